# Optimizing an MI355X kernel written in HIP

```python
import math
import jax, jax.numpy as jnp
from jax import lax
import numpy as np

D_MODEL = 2048
BATCH = 4
SEQ = 2048
DEPTH = 1
DEC_BATCH = 128
DEC_SEQ = 8
PAST_LEN = 16384
PAGE_SIZE = 128

ML_HEADS = 4
ML_DK = 256
ML_DV = 512
ML_QK = ML_HEADS * ML_DK
ML_V = ML_HEADS * ML_DV
HG_HEADS = 8
HG_DK = 128
HG_DV = 256
HG_K = HG_HEADS * HG_DK
HG_V = HG_HEADS * HG_DV
D_FF = 4 * D_MODEL
CHUNK = 64
LN_EPS = 1e-5
DEEPNORM_ALPHA = (2.0 * DEPTH) ** 0.25
DEEPNORM_BETA = (8.0 * DEPTH) ** -0.25
SPLITS = (ML_QK, ML_QK, ML_V, ML_HEADS, ML_HEADS, ML_V, HG_K, HG_K, HG_V, HG_V, D_MODEL, D_MODEL)
D_IN = sum(SPLITS)

kernel_name = "hybrid_mlstm_hgrn2_deepnorm_step"


def _layernorm(x, g, b):
    xf = x.astype(jnp.float32)
    mu = jnp.mean(xf, axis=-1, keepdims=True)
    var = jnp.mean(jnp.square(xf - mu), axis=-1, keepdims=True)
    return ((xf - mu) * lax.rsqrt(var + LN_EPS) * g.astype(jnp.float32) + b.astype(jnp.float32)).astype(x.dtype)


def _split_chunks(a, nc, L):
    a = a.reshape(a.shape[:2] + (nc, L) + a.shape[3:])
    return jnp.moveaxis(a, 2, 0)


def _merge_chunks(h):
    h = jnp.moveaxis(h, 0, 2)
    return h.reshape(h.shape[:2] + (h.shape[2] * h.shape[3],) + h.shape[4:])


def _mlstm(q, k, v, ig, lf, C0, n0, m0):
    T = q.shape[2]
    L = math.gcd(T, CHUNK)
    nc = T // L
    causal = jnp.tril(jnp.ones((L, L), dtype=bool))

    def step(carry, xs):
        C, n, m = carry
        qc, kc, vc, igc, lfc = xs
        b = jnp.cumsum(lfc, axis=-1)
        logd = b[..., :, None] - b[..., None, :] + igc[..., None, :]
        logd = jnp.where(causal, logd, -jnp.inf)
        inter = b + m[..., None]
        m_t = jnp.maximum(inter, jnp.max(logd, axis=-1))
        d = jnp.exp(logd - m_t[..., None])
        w_inter = jnp.exp(inter - m_t)
        s = jnp.einsum('bhtk,bhsk->bhts', qc, kc) * d
        num = jnp.einsum('bhts,bhsv->bhtv', s, vc) + w_inter[..., None] * jnp.einsum('bhtk,bhkv->bhtv', qc, C)
        den = jnp.sum(s, axis=-1) + w_inter * jnp.einsum('bhtk,bhk->bht', qc, n)
        h = num / jnp.maximum(jnp.abs(den), jnp.exp(-m_t))[..., None]
        m_new = m_t[..., -1]
        w_end = jnp.exp(b[..., -1:] - b + igc - m_new[..., None])
        decay = jnp.exp(b[..., -1] + m - m_new)
        C_new = decay[..., None, None] * C + jnp.einsum('bhs,bhsk,bhsv->bhkv', w_end, kc, vc)
        n_new = decay[..., None] * n + jnp.einsum('bhs,bhsk->bhk', w_end, kc)
        return (C_new, n_new, m_new), h

    xs = (_split_chunks(q, nc, L), _split_chunks(k, nc, L), _split_chunks(v, nc, L),
          _split_chunks(ig, nc, L), _split_chunks(lf, nc, L))
    (C, n, m), h = lax.scan(step, (C0, n0, m0), xs)
    return _merge_chunks(h), C, n, m


def _hgrn2(q, lf, kin, i, S0):
    T = q.shape[2]
    L = math.gcd(T, CHUNK)
    nc = T // L
    causal = jnp.tril(jnp.ones((L, L), dtype=bool))

    def step(S, xs):
        qc, lfc, kc, ic = xs
        G = jnp.cumsum(lfc, axis=2)
        rel = G[:, :, :, None, :] - G[:, :, None, :, :]
        rel = jnp.where(causal[:, :, None], rel, -jnp.inf)
        a = jnp.sum(qc[:, :, :, None, :] * jnp.exp(rel) * kc[:, :, None, :, :], axis=-1)
        o = jnp.einsum('bhts,bhsv->bhtv', a, ic) + jnp.einsum('bhtk,bhkv->bhtv', qc * jnp.exp(G), S)
        G_end = G[:, :, -1]
        S_new = jnp.exp(G_end)[..., None] * S + jnp.einsum('bhsk,bhsv->bhkv', kc * jnp.exp(G_end[:, :, None] - G), ic)
        return S_new, o

    xs = (_split_chunks(q, nc, L), _split_chunks(lf, nc, L), _split_chunks(kin, nc, L), _split_chunks(i, nc, L))
    S, o = lax.scan(step, S0, xs)
    return _merge_chunks(o), S


def _heads(a, n_heads):
    B, T, _ = a.shape
    return a.reshape(B, T, n_heads, -1).transpose(0, 2, 1, 3).astype(jnp.float32)


def _unheads(h):
    B, H, T, D = h.shape
    return h.transpose(0, 2, 1, 3).reshape(B, T, H * D)


def _layer(x, C0, n0, m0, S0, lb, w_in, b_ig, b_fg, ml_norm_g, hg_norm_g,
           w_branch_a, w_branch_b, w_out, ln1_g, ln1_b, w_up, w_down, ln2_g, ln2_b):
    f32 = jnp.float32
    offs = []
    acc = 0
    for s in SPLITS[:-1]:
        acc += s
        offs.append(acc)
    proj = jnp.einsum('btd,de->bte', x, w_in)
    (ml_q, ml_k, ml_v, ml_i, ml_f, ml_o, hg_q, hg_f, hg_i, hg_g, gate_a, gate_b) = jnp.split(proj, offs, axis=-1)

    q = _heads(ml_q, ML_HEADS)
    k = _heads(ml_k, ML_HEADS) * (ML_DK ** -0.5)
    v = _heads(ml_v, ML_HEADS)
    ig = (ml_i.astype(f32) + b_ig.astype(f32)).transpose(0, 2, 1)
    lf = jax.nn.log_sigmoid(ml_f.astype(f32) + b_fg.astype(f32)).transpose(0, 2, 1)
    h, C, n, m = _mlstm(q, k, v, ig, lf, C0.astype(f32), n0.astype(f32), m0.astype(f32))
    mu = jnp.mean(h, axis=-1, keepdims=True)
    var = jnp.mean(jnp.square(h - mu), axis=-1, keepdims=True)
    h = _unheads((h - mu) * lax.rsqrt(var + LN_EPS)) * ml_norm_g.astype(f32)
    branch_a = (h * jax.nn.sigmoid(ml_o.astype(f32))).astype(x.dtype)

    hq = _heads(hg_q, HG_HEADS)
    lbh = lb.reshape(HG_HEADS, 1, HG_DK)
    f = lbh + (1.0 - lbh) * jax.nn.sigmoid(_heads(hg_f, HG_HEADS))
    o, S = _hgrn2(hq, jnp.log(f), 1.0 - f, _heads(hg_i, HG_HEADS), S0.astype(f32))
    o = o * lax.rsqrt(jnp.mean(jnp.square(o), axis=-1, keepdims=True) + LN_EPS)
    o = _unheads(o) * hg_norm_g.astype(f32)
    branch_b = (o * jax.nn.silu(hg_g.astype(f32))).astype(x.dtype)

    ya = jnp.einsum('btv,vd->btd', branch_a, w_branch_a)
    yb = jnp.einsum('btv,vd->btd', branch_b, w_branch_b)
    merged = jax.nn.sigmoid(gate_a) * ya + jax.nn.sigmoid(gate_b) * yb
    mix = jnp.einsum('btd,de->bte', merged, w_out)
    x1 = _layernorm(DEEPNORM_ALPHA * x + mix, ln1_g, ln1_b)

    hid = jnp.square(jax.nn.relu(jnp.einsum('btd,df->btf', x1, w_up)))
    ff = jnp.einsum('btf,fd->btd', hid, w_down)
    y = _layernorm(DEEPNORM_ALPHA * x1 + ff, ln2_g, ln2_b)
    dt = x.dtype
    return y, C.astype(dt), n.astype(dt), m.astype(dt), S.astype(dt)


def setup_inputs(seed: int = 0) -> dict:
    key = jax.random.key(seed)
    ks = jax.random.split(key, 24)
    f32 = jnp.float32

    def nrm(k, shape, s):
        return jax.random.normal(k, shape, f32) * s

    return {
        "x_prompt": nrm(ks[0], (BATCH, SEQ, D_MODEL), 1.0),
        "x_sample": nrm(ks[1], (DEC_BATCH, DEC_SEQ, D_MODEL), 1.0),
        "state_mlstm_C": nrm(ks[2], (DEPTH, DEC_BATCH, ML_HEADS, ML_DK, ML_DV), 1.0),
        "state_mlstm_n": nrm(ks[3], (DEPTH, DEC_BATCH, ML_HEADS, ML_DK), 1.0),
        "state_mlstm_m": jax.random.uniform(ks[4], (DEPTH, DEC_BATCH, ML_HEADS), f32, 0.0, 3.0),
        "state_hgrn_S": nrm(ks[5], (DEPTH, DEC_BATCH, HG_HEADS, HG_DK, HG_DV), 1.0),
        "hg_lb_logits": nrm(ks[6], (DEPTH + 1, HG_K), 0.1),
        "w_in": nrm(ks[7], (DEPTH, D_MODEL, D_IN), D_MODEL ** -0.5),
        "b_ig": nrm(ks[8], (DEPTH, ML_HEADS), 0.1),
        "b_fg": jnp.linspace(3.0, 6.0, ML_HEADS, dtype=f32)[None, :] + nrm(ks[9], (DEPTH, ML_HEADS), 0.1),
        "ml_norm_g": 1.0 + nrm(ks[10], (DEPTH, ML_V), 0.05),
        "hg_norm_g": 1.0 + nrm(ks[11], (DEPTH, HG_V), 0.05),
        "w_branch_a": nrm(ks[12], (DEPTH, ML_V, D_MODEL), ML_V ** -0.5),
        "w_branch_b": nrm(ks[13], (DEPTH, HG_V, D_MODEL), HG_V ** -0.5),
        "w_out": nrm(ks[14], (DEPTH, D_MODEL, D_MODEL), DEEPNORM_BETA * D_MODEL ** -0.5),
        "ln1_g": 1.0 + nrm(ks[15], (DEPTH, D_MODEL), 0.05),
        "ln1_b": nrm(ks[16], (DEPTH, D_MODEL), 0.02),
        "w_up": nrm(ks[17], (DEPTH, D_MODEL, D_FF), D_MODEL ** -0.5),
        "w_down": nrm(ks[18], (DEPTH, D_FF, D_MODEL), DEEPNORM_BETA * D_FF ** -0.5),
        "ln2_g": 1.0 + nrm(ks[19], (DEPTH, D_MODEL), 0.05),
        "ln2_b": nrm(ks[20], (DEPTH, D_MODEL), 0.02),
    }


def reference(x_prompt, x_sample, state_mlstm_C, state_mlstm_n, state_mlstm_m, state_hgrn_S,
              hg_lb_logits, w_in, b_ig, b_fg, ml_norm_g, hg_norm_g, w_branch_a, w_branch_b, w_out,
              ln1_g, ln1_b, w_up, w_down, ln2_g, ln2_b):
    dt = x_prompt.dtype
    lb_all = jnp.cumsum(jax.nn.softmax(hg_lb_logits.astype(jnp.float32), axis=0), axis=0)
    xp, xs = x_prompt, x_sample
    Cp_l, np_l, mp_l, Sp_l = [], [], [], []
    Cs_l, ns_l, ms_l, Ss_l = [], [], [], []
    for l in range(DEPTH):
        params = (lb_all[l], w_in[l], b_ig[l], b_fg[l], ml_norm_g[l], hg_norm_g[l],
                  w_branch_a[l], w_branch_b[l], w_out[l], ln1_g[l], ln1_b[l], w_up[l], w_down[l], ln2_g[l], ln2_b[l])
        C0 = jnp.zeros((BATCH, ML_HEADS, ML_DK, ML_DV), dt)
        n0 = jnp.zeros((BATCH, ML_HEADS, ML_DK), dt)
        m0 = jnp.zeros((BATCH, ML_HEADS), dt)
        S0 = jnp.zeros((BATCH, HG_HEADS, HG_DK, HG_DV), dt)
        xp, Cp, n_p, mp, Sp = _layer(xp, C0, n0, m0, S0, *params)
        xs, Cs, n_s, ms, Ss = _layer(xs, state_mlstm_C[l], state_mlstm_n[l], state_mlstm_m[l], state_hgrn_S[l], *params)
        Cp_l.append(Cp); np_l.append(n_p); mp_l.append(mp); Sp_l.append(Sp)
        Cs_l.append(Cs); ns_l.append(n_s); ms_l.append(ms); Ss_l.append(Ss)
    return (xp, xs,
            jnp.stack(Cp_l), jnp.stack(np_l), jnp.stack(mp_l), jnp.stack(Sp_l),
            jnp.stack(Cs_l), jnp.stack(ns_l), jnp.stack(ms_l), jnp.stack(Ss_l))
```

```cpp
#include <hip/hip_runtime.h>
#include <hip/hip_cooperative_groups.h>
#include <cstdio>
#include <cstdint>
namespace cg = cooperative_groups;

#define LAS __attribute__((address_space(3)))
typedef unsigned short bf16_t;
typedef short bf16x8 __attribute__((ext_vector_type(8)));
typedef short bf16x4 __attribute__((ext_vector_type(4)));
typedef float f32x4 __attribute__((ext_vector_type(4)));
typedef float f32x2 __attribute__((ext_vector_type(2)));
typedef unsigned u32x4 __attribute__((ext_vector_type(4)));
typedef unsigned u32x2 __attribute__((ext_vector_type(2)));

constexpr int D = 2048, NTP = 8192, NTS = 1024, NT = 9216, DIN = 16392, NP = 16384, DFF = 8192;
constexpr int C_MLQ = 0, C_MLK = 1024, C_MLV = 2048, C_MLO = 4096, C_HGQ = 6144, C_HGF = 7168, C_HGI = 8192, C_HGG = 10240, C_GA = 12288, C_GB = 14336;
constexpr float LN_EPS = 1e-5f;
constexpr float ALPHA = 1.189207115002721f;
constexpr size_t O_Y = 0, O_CP = 18874368, O_NP = 20971520, O_MP = 20975616, O_SP = 20975632, O_CS = 22024208, O_NS = 89133072, O_MS = 89264144, O_SS = 89264656;
constexpr size_t WS_CTL = 0;
constexpr size_t WS_WIN = 4096;
constexpr size_t WS_WA = WS_WIN + (size_t)NP * D * 2;
constexpr size_t WS_WB = WS_WA + (size_t)D * D * 2;
constexpr size_t WS_WOUT = WS_WB + (size_t)D * D * 2;
constexpr size_t WS_WUP = WS_WOUT + (size_t)D * D * 2;
constexpr size_t WS_WDN = WS_WUP + (size_t)DFF * D * 2;
constexpr size_t WS_XB = WS_WDN + (size_t)DFF * D * 2;
constexpr size_t WS_GATES = WS_XB + (size_t)NT * D * 2;
constexpr size_t WS_DEN = WS_GATES + (size_t)NT * 8 * 4;
constexpr size_t WS_MT = WS_DEN + (size_t)NT * 4 * 4;
constexpr size_t WS_PROJ = WS_MT + (size_t)NT * 4 * 4;
constexpr size_t WS_HA = WS_PROJ + (size_t)NT * NP * 2;
constexpr size_t WS_OB = WS_HA + (size_t)NT * D * 4;
constexpr size_t WS_BRA = WS_OB + (size_t)NT * D * 4;
constexpr size_t WS_BRB = WS_BRA + (size_t)NT * D * 2;
constexpr size_t WS_MRG = WS_BRB + (size_t)NT * D * 2;
constexpr size_t WS_END = WS_MRG + (size_t)NT * D * 2;
constexpr size_t WS_TMP = WS_HA;
constexpr size_t WS_Z1 = WS_OB;
constexpr size_t WS_X1F = WS_PROJ;
constexpr size_t WS_X1B = WS_X1F + (size_t)NT * D * 4;
constexpr size_t WS_HID = WS_X1B + (size_t)NT * D * 2;
constexpr size_t WS_Z2 = WS_HA;
static_assert(WS_HID + (size_t)NT * DFF * 2 <= WS_HA, "overlay overflow");

constexpr int LDS_BYTES = 163840;

struct Params {
    const float *xp, *xs, *C0, *n0, *m0, *S0, *lbl, *w_in, *b_ig, *b_fg, *mlg, *hgg, *w_a, *w_b, *w_out, *ln1g, *ln1b, *w_up, *w_dn, *ln2g, *ln2b;
    float* out; unsigned char* ws;
    int ph_lo, ph_hi;
};

__device__ __forceinline__ unsigned pk2(float lo, float hi) { unsigned r; asm("v_cvt_pk_bf16_f32 %0, %1, %2" : "=v"(r) : "v"(lo), "v"(hi)); return r; }
__device__ __forceinline__ float bflo(unsigned u) { return __uint_as_float(u << 16); }
__device__ __forceinline__ float bfhi(unsigned u) { return __uint_as_float(u & 0xffff0000u); }
__device__ __forceinline__ float bf1(unsigned short b) { return __uint_as_float(((unsigned)b) << 16); }
__device__ __forceinline__ float sigmoidf_(float x) { return __builtin_amdgcn_rcpf(1.f + __expf(-x)); }
__device__ __forceinline__ float wave_sum(float v) {
#pragma unroll
    for (int o = 1; o < 64; o <<= 1) v += __shfl_xor(v, o);
    return v;
}
#define LDS_WAIT() asm volatile("s_waitcnt lgkmcnt(0)" ::: "memory")

namespace pg8 {
#define PG8_LAS __attribute__((address_space(3)))
constexpr int BM = 256, BK = 64, HALF = 128, HTB = HALF * BK * 2, STAGE_BYTES = 8 * HTB, NXCD = 8, WGM = 8;
__host__ __device__ __forceinline__ int lds_byte(int r, int c) { const int st = (r >> 4) * 2 + (c >> 5), rr = r & 15, cc = c & 31, ob = rr * 64 + cc * 2; return st * 1024 + (ob ^ (((ob >> 9) & 1) << 5)); }
__host__ __device__ __forceinline__ void stage_rc(int b, int& R, int& C) { const int st = b / 1024, sb = b % 1024, swz = sb ^ (((sb >> 9) & 1) << 5); R = (st >> 1) * 16 + swz / 64; C = (st & 1) * 32 + (swz % 64) / 2; }
__host__ __device__ __forceinline__ int perm32(int rho) { const int n = rho >> 4, i = rho & 15; return 8 * (i >> 2) + 4 * n + (i & 3); }
struct Unit { int pm, pn; };
struct Gemm { const bf16_t* A; const bf16_t* Bt; int M, N, K; };
struct StaticOrder {
    int nM, nN, nwg, G, c;
    __host__ __device__ void init(int M, int N, int G_, int c_) { nM = M / BM; nN = N / BM; nwg = nM * nN; G = G_; c = c_; }
    __host__ __device__ bool next(int i, Unit& u) const {
        const long L = (long)i * G + c; if (L >= nwg) return false;
        int wgid = (int)L; { const int q = nwg / NXCD, r = nwg % NXCD, xcd = wgid % NXCD, off = wgid / NXCD; wgid = (xcd < r ? xcd * (q + 1) : r * (q + 1) + (xcd - r) * q) + off; }
        const int nig = WGM * nN, gid = wgid / nig, fm = gid * WGM, gsz = (nM - fm) < WGM ? (nM - fm) : WGM;
        u.pm = fm + ((wgid % nig) % gsz); u.pn = (wgid % nig) / gsz; return true;
    }
    __device__ __forceinline__ void a_ready(const Unit&) const {}
    __device__ __forceinline__ void done(const Unit&) const {}
};
struct EpiProj {
    static constexpr bool PERM = true, AFTER_DRAIN = false;
    bf16_t* O; int ldc;
    __device__ __forceinline__ void operator()(const f32x4 (&acc)[2][2][4][2], const Unit& u, int wr, int wc, int fr, int fq) const {
        const int row0 = u.pm * BM + wr * 64 + fr, col0 = u.pn * BM + wc * 32 + 8 * fq;
#pragma unroll
        for (int ai = 0; ai < 2; ++ai)
#pragma unroll
            for (int m = 0; m < 4; ++m) { bf16_t* rowp = O + (size_t)(row0 + ai * HALF + m * 16) * ldc + col0;
#pragma unroll
                for (int bj = 0; bj < 2; ++bj) { const f32x4 v0 = acc[ai][bj][m][0], v1 = acc[ai][bj][m][1];
                    u32x4 o; o.x = pk2(v0[0], v0[1]); o.y = pk2(v0[2], v0[3]); o.z = pk2(v1[0], v1[1]); o.w = pk2(v1[2], v1[3]);
                    *(u32x4*)(rowp + bj * HALF) = o; } }
    }
};
struct EpiHid {
    static constexpr bool PERM = true, AFTER_DRAIN = false;
    bf16_t* O; int ldc;
    __device__ __forceinline__ void operator()(const f32x4 (&acc)[2][2][4][2], const Unit& u, int wr, int wc, int fr, int fq) const {
        const int row0 = u.pm * BM + wr * 64 + fr, col0 = u.pn * BM + wc * 32 + 8 * fq;
#pragma unroll
        for (int ai = 0; ai < 2; ++ai)
#pragma unroll
            for (int m = 0; m < 4; ++m) { bf16_t* rowp = O + (size_t)(row0 + ai * HALF + m * 16) * ldc + col0;
#pragma unroll
                for (int bj = 0; bj < 2; ++bj) { f32x4 v0 = acc[ai][bj][m][0], v1 = acc[ai][bj][m][1];
#pragma unroll
                    for (int e = 0; e < 4; ++e) { const float a = fmaxf(v0[e], 0.f), b = fmaxf(v1[e], 0.f); v0[e] = a * a; v1[e] = b * b; }
                    u32x4 o; o.x = pk2(v0[0], v0[1]); o.y = pk2(v0[2], v0[3]); o.z = pk2(v1[0], v1[1]); o.w = pk2(v1[2], v1[3]);
                    *(u32x4*)(rowp + bj * HALF) = o; } }
    }
};
template <int PASS> struct EpiMerge {
    static constexpr bool PERM = true, AFTER_DRAIN = false;
    const bf16_t* proj; float* tmp; bf16_t* O;
    __device__ __forceinline__ void operator()(const f32x4 (&acc)[2][2][4][2], const Unit& u, int wr, int wc, int fr, int fq) const {
        const int row0 = u.pm * BM + wr * 64 + fr, col0 = u.pn * BM + wc * 32 + 8 * fq;
#pragma unroll
        for (int ai = 0; ai < 2; ++ai)
#pragma unroll
            for (int m = 0; m < 4; ++m) { const size_t row = (size_t)(row0 + ai * HALF + m * 16);
#pragma unroll
                for (int bj = 0; bj < 2; ++bj) { const int col = col0 + bj * HALF;
                    const u32x4 gv = *(const u32x4*)(proj + row * NP + (PASS == 0 ? C_GA : C_GB) + col);
                    f32x4 s0, s1;
                    s0[0] = sigmoidf_(bflo(gv.x)); s0[1] = sigmoidf_(bfhi(gv.x)); s0[2] = sigmoidf_(bflo(gv.y)); s0[3] = sigmoidf_(bfhi(gv.y));
                    s1[0] = sigmoidf_(bflo(gv.z)); s1[1] = sigmoidf_(bfhi(gv.z)); s1[2] = sigmoidf_(bflo(gv.w)); s1[3] = sigmoidf_(bfhi(gv.w));
                    f32x4 v0 = acc[ai][bj][m][0] * s0, v1 = acc[ai][bj][m][1] * s1;
                    float* tp = tmp + row * D + col;
                    if (PASS == 0) { *(f32x4*)tp = v0; *(f32x4*)(tp + 4) = v1; }
                    else { v0 += *(const f32x4*)tp; v1 += *(const f32x4*)(tp + 4);
                        u32x4 o; o.x = pk2(v0[0], v0[1]); o.y = pk2(v0[2], v0[3]); o.z = pk2(v1[0], v1[1]); o.w = pk2(v1[2], v1[3]);
                        *(u32x4*)(O + row * D + col) = o; }
                    __builtin_amdgcn_sched_barrier(0); } }
    }
};
struct EpiRes {
    static constexpr bool PERM = false, AFTER_DRAIN = false;
    const float* rA; const float* rB; int split; float* Z;
    __device__ __forceinline__ void operator()(const f32x4 (&acc)[2][2][4][2], const Unit& u, int wr, int wc, int fr, int fq) const {
        const int row0 = u.pm * BM + wr * 64 + fr, col0 = u.pn * BM + wc * 32 + 4 * fq;
#pragma unroll
        for (int ai = 0; ai < 2; ++ai)
#pragma unroll
            for (int m = 0; m < 4; ++m) { const int row = row0 + ai * HALF + m * 16;
                const float* rp = (row < split ? rA + (size_t)row * D : rB + (size_t)(row - split) * D) + col0;
                float* zp = Z + (size_t)row * D + col0;
#pragma unroll
                for (int bj = 0; bj < 2; ++bj)
#pragma unroll
                    for (int n = 0; n < 2; ++n) { const f32x4 r = *(const f32x4*)(rp + bj * HALF + n * 16);
                        *(f32x4*)(zp + bj * HALF + n * 16) = r * ALPHA + acc[ai][bj][m][n]; } }
    }
};

template <class Epi, class Sched>
__device__ __forceinline__ void gemm_phase(PG8_LAS unsigned char* lds, const Gemm g, const Sched& S, const Epi& E) {
    const int tid = threadIdx.x, wid = __builtin_amdgcn_readfirstlane(tid >> 6), lane = tid & 63, wr = wid >> 2, wc = wid & 3, fr = lane & 15, fq = lane >> 4;
    const int K = g.K, nt = K / BK;
    unsigned voffA[2], voffB[2];
#pragma unroll
    for (int i = 0; i < 2; ++i) { int R, C; stage_rc(tid * 16 + i * 8192, R, C); const int Rb = Epi::PERM ? ((R & ~31) + perm32(R & 31)) : R;
        voffA[i] = (unsigned)(R * K + C) * 2u; voffB[i] = (unsigned)(Rb * K + C) * 2u; }
    const size_t kstep = (size_t)(BK * 2);
    const size_t hstep = (size_t)HALF * K * 2;
    const size_t tstep = 2 * hstep;
    const unsigned ldsw = (unsigned)wid * 1024u;
    const int aoff = lds_byte(wr * 64 + fr, fq * 8), boff = lds_byte(wc * 32 + fr, fq * 8);
#define PG8_SA(b, h) (((b) * 2 + (h)) * HTB)
#define PG8_SB(b, h) ((4 + (b) * 2 + (h)) * HTB)
#define PG8_STAGE(bufoff, gbase, voff) do { _Pragma("unroll") for (int _i = 0; _i < 2; ++_i) \
        __builtin_amdgcn_global_load_lds((const unsigned*)((const char*)(gbase) + (voff)[_i]), (PG8_LAS unsigned*)(lds + (bufoff) + ldsw + _i * 8192), 16, 0, 0); } while (0)
#define PG8_LDA(dst, b, h) do { _Pragma("unroll") for (int m = 0; m < 4; ++m) _Pragma("unroll") for (int k = 0; k < 2; ++k) dst[m][k] = *(const PG8_LAS bf16x8*)(lds + PG8_SA(b, h) + aoff + m * 2048 + k * 1024); } while (0)
#define PG8_LDB(dst, b, h) do { _Pragma("unroll") for (int n = 0; n < 2; ++n) _Pragma("unroll") for (int k = 0; k < 2; ++k) dst[n][k] = *(const PG8_LAS bf16x8*)(lds + PG8_SB(b, h) + boff + n * 2048 + k * 1024); } while (0)
#define PG8_MMA(ai, bj, At, Bt) do { __builtin_amdgcn_s_setprio(1); _Pragma("unroll") for (int m = 0; m < 4; ++m) _Pragma("unroll") for (int n = 0; n < 2; ++n) _Pragma("unroll") for (int k = 0; k < 2; ++k) \
        acc[ai][bj][m][n] = __builtin_amdgcn_mfma_f32_16x16x32_bf16(Bt[n][k], At[m][k], acc[ai][bj][m][n], 0, 0, 0); __builtin_amdgcn_s_setprio(0); } while (0)
#define PG8_WAIT_V(n) asm volatile("s_waitcnt vmcnt(" #n ")" ::: "memory")
#define PG8_WAIT_L(n) asm volatile("s_waitcnt lgkmcnt(" #n ")" ::: "memory")
#define PG8_BAR __builtin_amdgcn_s_barrier()
#define PG8_SCHED __builtin_amdgcn_sched_barrier(0)
    Unit cur, nxt; int ui = 0;
    if (!S.next(0, cur)) return;
    f32x4 acc[2][2][4][2];
#pragma unroll
    for (int a = 0; a < 2; ++a)
#pragma unroll
        for (int b = 0; b < 2; ++b)
#pragma unroll
            for (int m = 0; m < 4; ++m)
#pragma unroll
                for (int n = 0; n < 2; ++n) acc[a][b][m][n] = (f32x4){0.f, 0.f, 0.f, 0.f};
    bf16x8 At[4][2], B0[2][2], B1[2][2];
    const char* cA = (const char*)g.A + (size_t)cur.pm * tstep; const char* cB = (const char*)g.Bt + (size_t)cur.pn * tstep;
    S.a_ready(cur);
    PG8_STAGE(PG8_SB(0, 0), cB, voffB); PG8_STAGE(PG8_SA(0, 0), cA, voffA); PG8_STAGE(PG8_SB(0, 1), cB + hstep, voffB); PG8_STAGE(PG8_SA(0, 1), cA + hstep, voffA);
    if (wr == 1) PG8_BAR;
    PG8_WAIT_V(4); PG8_BAR;
    PG8_STAGE(PG8_SB(1, 0), cB + kstep, voffB); PG8_STAGE(PG8_SA(1, 0), cA + kstep, voffA); PG8_STAGE(PG8_SB(1, 1), cB + hstep + kstep, voffB);
    PG8_WAIT_V(6); PG8_BAR;
    for (;;) {
        const bool has_next = S.next(ui + 1, nxt);
        const char* nA = has_next ? (const char*)g.A + (size_t)nxt.pm * tstep : cA; const char* nB = has_next ? (const char*)g.Bt + (size_t)nxt.pn * tstep : cB;
        for (int t = 0; t < nt; t += 2) {
            const bool last = (t == nt - 2);
            const char* a1 = cA + (size_t)(t + 1) * kstep;
            const char* a2 = last ? nA : cA + (size_t)(t + 2) * kstep; const char* b2 = last ? nB : cB + (size_t)(t + 2) * kstep;
            const char* a3 = a2 + kstep; const char* b3 = b2 + kstep;
            if (last && has_next) S.a_ready(nxt);
            PG8_LDB(B0, 0, 0); PG8_SCHED; PG8_LDA(At, 0, 0); PG8_STAGE(PG8_SA(1, 1), a1 + hstep, voffA);
            PG8_WAIT_L(8); PG8_BAR; PG8_WAIT_L(0); PG8_MMA(0, 0, At, B0); PG8_BAR; PG8_SCHED;
            PG8_LDB(B1, 0, 1); PG8_STAGE(PG8_SB(0, 0), b2, voffB);
            PG8_BAR; PG8_WAIT_L(0); PG8_MMA(0, 1, At, B1); PG8_BAR;
            PG8_LDA(At, 0, 1); PG8_STAGE(PG8_SA(0, 0), a2, voffA);
            PG8_BAR; PG8_WAIT_L(0); PG8_MMA(1, 0, At, B0); PG8_BAR; PG8_SCHED;
            PG8_STAGE(PG8_SB(0, 1), b2 + hstep, voffB);
            PG8_WAIT_V(6); PG8_BAR; PG8_MMA(1, 1, At, B1); PG8_BAR;
            PG8_LDB(B0, 1, 0); PG8_SCHED; PG8_LDA(At, 1, 0); PG8_STAGE(PG8_SA(0, 1), a2 + hstep, voffA);
            PG8_WAIT_L(8); PG8_BAR; PG8_WAIT_L(0); PG8_MMA(0, 0, At, B0); PG8_BAR; PG8_SCHED;
            PG8_LDB(B1, 1, 1); PG8_STAGE(PG8_SB(1, 0), b3, voffB);
            PG8_BAR; PG8_WAIT_L(0); PG8_MMA(0, 1, At, B1); PG8_BAR;
            PG8_LDA(At, 1, 1); PG8_STAGE(PG8_SA(1, 0), a3, voffA);
            PG8_BAR; PG8_WAIT_L(0); PG8_MMA(1, 0, At, B0); PG8_BAR; PG8_SCHED;
            PG8_STAGE(PG8_SB(1, 1), b3 + hstep, voffB);
            PG8_WAIT_V(6); PG8_BAR; PG8_MMA(1, 1, At, B1); PG8_BAR;
        }
        if constexpr (!Epi::AFTER_DRAIN) { E(acc, cur, wr, wc, fr, fq); S.done(cur); }
        if (!has_next) break;
#pragma unroll
        for (int a = 0; a < 2; ++a)
#pragma unroll
            for (int b = 0; b < 2; ++b)
#pragma unroll
                for (int m = 0; m < 4; ++m)
#pragma unroll
                    for (int n = 0; n < 2; ++n) acc[a][b][m][n] = (f32x4){0.f, 0.f, 0.f, 0.f};
        cur = nxt; cA = nA; cB = nB; ++ui;
    }
    PG8_WAIT_V(0);
    if (wr == 0) PG8_BAR;
    PG8_BAR;
    if constexpr (Epi::AFTER_DRAIN) { E.fused(acc, cur, wr, wc, fr, fq, lds, wid, lane); S.done(cur); }
#undef PG8_SA
#undef PG8_SB
#undef PG8_STAGE
#undef PG8_LDA
#undef PG8_LDB
#undef PG8_MMA
#undef PG8_WAIT_V
#undef PG8_WAIT_L
#undef PG8_BAR
#undef PG8_SCHED
}
}

__device__ __forceinline__ void transpose_item(const float* __restrict__ W, int src_ld, int src_col, bf16_t* __restrict__ WT, int K, int dst_row, int k0, LAS float* scr, int lane) {
#pragma unroll 8
    for (int i = 0; i < 32; ++i) { const int kk = 2 * i + (lane >> 5); scr[kk * 33 + (lane & 31)] = W[(size_t)(k0 + kk) * src_ld + src_col + (lane & 31)]; }
    LDS_WAIT();
    const int c = lane & 7;
#pragma unroll
    for (int j = 0; j < 4; ++j) { const int n = (lane >> 3) + 8 * j; const LAS float* s = scr + (8 * c) * 33 + n;
        u32x4 o; o.x = pk2(s[0 * 33], s[1 * 33]); o.y = pk2(s[2 * 33], s[3 * 33]); o.z = pk2(s[4 * 33], s[5 * 33]); o.w = pk2(s[6 * 33], s[7 * 33]);
        *(u32x4*)(WT + (size_t)(dst_row + n) * K + k0 + 8 * c) = o; }
    LDS_WAIT();
}
__device__ __forceinline__ float log_sigmoid_(float x) { return fminf(x, 0.f) - log1pf(expf(-fabsf(x))); }

__device__ __forceinline__ void phase_prep(const Params& p, LAS unsigned char* lds) {
    const int tid = threadIdx.x, lane = tid & 63, wave = tid >> 6;
    LAS float* wg = (LAS float*)lds;
    LAS float* scr = (LAS float*)(lds + 65536 + wave * 8704);
    for (int d = tid; d < D; d += 512) {
        const f32x4 a = *(const f32x4*)(p.w_in + (size_t)d * DIN + 4096), b = *(const f32x4*)(p.w_in + (size_t)d * DIN + 4100);
        *(LAS f32x4*)(wg + d * 8) = a; *(LAS f32x4*)(wg + d * 8 + 4) = b;
    }
    bf16_t* WIN = (bf16_t*)(p.ws + WS_WIN); bf16_t* WA = (bf16_t*)(p.ws + WS_WA); bf16_t* WB = (bf16_t*)(p.ws + WS_WB);
    bf16_t* WOUT = (bf16_t*)(p.ws + WS_WOUT); bf16_t* WUP = (bf16_t*)(p.ws + WS_WUP); bf16_t* WDN = (bf16_t*)(p.ws + WS_WDN);
    const int gw = blockIdx.x * 8 + wave, NGW = gridDim.x * 8;
    constexpr int I_IN = 32 * 512, I_SQ = 32 * 64, I_UP = 32 * 256, I_DN = 128 * 64, NITEMS = I_IN + 3 * I_SQ + I_UP + I_DN;
    for (int it = gw; it < NITEMS; it += NGW) {
        int r = it;
        if (r < I_IN) { const int kb = r >> 9, nb = r & 511, n0 = nb * 32; transpose_item(p.w_in, DIN, n0 + (n0 >= 4096 ? 8 : 0), WIN, D, n0, kb * 64, scr, lane); continue; } r -= I_IN;
        if (r < I_SQ) { const int kb = r >> 6, nb = r & 63; transpose_item(p.w_a, D, nb * 32, WA, D, nb * 32, kb * 64, scr, lane); continue; } r -= I_SQ;
        if (r < I_SQ) { const int kb = r >> 6, nb = r & 63; transpose_item(p.w_b, D, nb * 32, WB, D, nb * 32, kb * 64, scr, lane); continue; } r -= I_SQ;
        if (r < I_SQ) { const int kb = r >> 6, nb = r & 63; transpose_item(p.w_out, D, nb * 32, WOUT, D, nb * 32, kb * 64, scr, lane); continue; } r -= I_SQ;
        if (r < I_UP) { const int kb = r >> 8, nb = r & 255; transpose_item(p.w_up, DFF, nb * 32, WUP, D, nb * 32, kb * 64, scr, lane); continue; } r -= I_UP;
        { const int kb = r >> 6, nb = r & 63; transpose_item(p.w_dn, D, nb * 32, WDN, DFF, nb * 32, kb * 64, scr, lane); }
    }
    __syncthreads();
    bf16_t* XB = (bf16_t*)(p.ws + WS_XB); float* GATES = (float*)(p.ws + WS_GATES);
    for (int row = gw; row < NT; row += NGW) {
        const float* xr = row < NTP ? p.xp + (size_t)row * D : p.xs + (size_t)(row - NTP) * D;
        float gs[8];
#pragma unroll
        for (int e = 0; e < 8; ++e) gs[e] = 0.f;
#pragma unroll
        for (int j = 0; j < 8; ++j) {
            const f32x4 v = ((const f32x4*)xr)[lane + 64 * j];
            u32x2 o; o.x = pk2(v[0], v[1]); o.y = pk2(v[2], v[3]);
            ((u32x2*)(XB + (size_t)row * D))[lane + 64 * j] = o;
#pragma unroll
            for (int e = 0; e < 4; ++e) { const int d = 4 * (lane + 64 * j) + e;
                const f32x4 w0 = *(const LAS f32x4*)(wg + d * 8), w1 = *(const LAS f32x4*)(wg + d * 8 + 4);
#pragma unroll
                for (int q = 0; q < 4; ++q) { gs[q] += v[e] * w0[q]; gs[4 + q] += v[e] * w1[q]; } }
        }
#pragma unroll
        for (int e = 0; e < 8; ++e) gs[e] = wave_sum(gs[e]);
        if (lane < 4) { float gi = lane == 0 ? gs[0] : lane == 1 ? gs[1] : lane == 2 ? gs[2] : gs[3];
            float gf = lane == 0 ? gs[4] : lane == 1 ? gs[5] : lane == 2 ? gs[6] : gs[7];
            GATES[(size_t)row * 8 + lane] = gi + p.b_ig[lane];
            GATES[(size_t)row * 8 + 4 + lane] = log_sigmoid_(gf + p.b_fg[lane]); }
    }
}

template <bool IS_ML>
__device__ __forceinline__ void chain_item(const Params& p, LAS unsigned char* lds, int bh, int sl) {
    constexpr int DK = IS_ML ? 256 : 128, NPC = DK / 64, NRB = DK / 16;
    constexpr int QS = (DK + 8) * 2, TS = 144, VRS = 272;
    constexpr int OFF_Q = 0, OFF_K = OFF_Q + 64 * QS, OFF_KT = OFF_K + 64 * QS, OFF_VT = OFF_KT + DK * TS, OFF_VR = OFF_VT + 128 * TS, OFF_P = OFF_VR + 64 * VRS, OFF_SM = OFF_P + 64 * TS;
    static_assert(OFF_SM + 10240 + 16 <= LDS_BYTES, "chain LDS");
    const int tid = threadIdx.x, lane = tid & 63, w = tid >> 6, g = lane >> 4, c16 = lane & 15;
    const int b = IS_ML ? (bh >> 2) : (bh >> 3), h = IS_ML ? (bh & 3) : (bh & 7);
    const bool isden = IS_ML && sl == 4;
    const int qcol = IS_ML ? C_MLQ + h * 256 : C_HGQ + h * 128, kcol = IS_ML ? C_MLK + h * 256 : C_HGF + h * 128;
    const int vcol = IS_ML ? C_MLV + h * 512 + (isden ? 0 : sl) * 128 : C_HGI + h * 256 + sl * 128;
    const bf16_t* proj = (const bf16_t*)(p.ws + WS_PROJ);
    const float* GATES = (const float*)(p.ws + WS_GATES);
    const size_t tok0 = (size_t)b * 2048;
    LAS unsigned char* Q = lds + OFF_Q; LAS unsigned char* Kr = lds + OFF_K; LAS unsigned char* KT = lds + OFF_KT;
    LAS unsigned char* VT = lds + OFF_VT; LAS unsigned char* VR = lds + OFF_VR; LAS unsigned char* P = lds + OFF_P;
    LAS float* SM = (LAS float*)(lds + OFF_SM);
    LAS float* SMW = SM + w * 320;
    const int prow = tid >> 3, pseg = tid & 7;
    u32x4 pq[NPC], pk[NPC], pv[2]; float pig = 0.f, plf = 0.f;
    auto prefetch = [&](int c) {
        const bf16_t* rp = proj + (tok0 + c * 64 + prow) * NP;
#pragma unroll
        for (int i = 0; i < NPC; ++i) { pq[i] = *(const u32x4*)(rp + qcol + i * 64 + pseg * 8); pk[i] = *(const u32x4*)(rp + kcol + i * 64 + pseg * 8); }
        if (!isden) {
#pragma unroll
            for (int i = 0; i < 2; ++i) pv[i] = *(const u32x4*)(rp + vcol + i * 64 + pseg * 8); }
        if (IS_ML) { pig = GATES[(tok0 + c * 64 + lane) * 8 + h]; plf = GATES[(tok0 + c * 64 + lane) * 8 + 4 + h]; }
    };
    prefetch(0);
    f32x4 S[NRB];
#pragma unroll
    for (int i = 0; i < NRB; ++i) S[i] = (f32x4){0.f, 0.f, 0.f, 0.f};
    float m_prev = 0.f;
    float lbk = 0.f;
    if (!IS_ML) { const int k = tid & 127; lbk = sigmoidf_(p.lbl[h * 128 + k] - p.lbl[1024 + h * 128 + k]); }
    float* OUT = (float*)(p.ws + (IS_ML ? WS_HA : WS_OB));
    const int ocol = IS_ML ? h * 512 + sl * 128 + w * 16 + c16 : h * 256 + sl * 128 + w * 16 + c16;

    for (int c = 0; c < 32; ++c) {
#pragma unroll
        for (int i = 0; i < NPC; ++i) { *(LAS u32x4*)(Q + prow * QS + (i * 64 + pseg * 8) * 2) = pq[i]; *(LAS u32x4*)(Kr + prow * QS + (i * 64 + pseg * 8) * 2) = pk[i]; }
        if (!isden) {
#pragma unroll
            for (int i = 0; i < 2; ++i) *(LAS u32x4*)(VR + prow * VRS + (i * 64 + pseg * 8) * 2) = pv[i]; }
        const float ig = pig, lf = plf;
        if (c + 1 < 32) prefetch(c + 1);
        __syncthreads();
        float a_t = 0.f, M_t = 0.f, wint = 1.f, mt = 0.f, decay = 1.f, m_new = 0.f;
        if (IS_ML) {
            float bt = lf;
#pragma unroll
            for (int o = 1; o < 64; o <<= 1) { const float y = __shfl_up(bt, o); if (lane >= o) bt += y; }
            a_t = ig - bt;
            float cm = a_t;
#pragma unroll
            for (int o = 1; o < 64; o <<= 1) { const float y = __shfl_up(cm, o); if (lane >= o) cm = fmaxf(cm, y); }
            M_t = fmaxf(m_prev, cm);
            const float M_end = __shfl(M_t, 63), b_end = __shfl(bt, 63);
            wint = __expf(m_prev - M_t); mt = bt + M_t;
            const float wend = __expf(a_t - M_end);
            decay = __expf(m_prev - M_end); m_new = b_end + M_end;
            SMW[lane] = a_t; SMW[64 + lane] = M_t; SMW[128 + lane] = wint; SMW[192 + lane] = mt; SMW[256 + lane] = wend;
            LDS_WAIT();
            { const int sp = tid & 31, seg = tid >> 5;
                const f32x2 wv = *(const LAS f32x2*)(SMW + 256 + 2 * sp); const float w0 = wv[0] * 0.0625f, w1 = wv[1] * 0.0625f;
                const u32x4 r0a = *(const LAS u32x4*)(Kr + (2 * sp) * QS + seg * 32), r0b = *(const LAS u32x4*)(Kr + (2 * sp) * QS + seg * 32 + 16);
                const u32x4 r1a = *(const LAS u32x4*)(Kr + (2 * sp + 1) * QS + seg * 32), r1b = *(const LAS u32x4*)(Kr + (2 * sp + 1) * QS + seg * 32 + 16);
                const unsigned x0[8] = {r0a.x, r0a.y, r0a.z, r0a.w, r0b.x, r0b.y, r0b.z, r0b.w};
                const unsigned x1[8] = {r1a.x, r1a.y, r1a.z, r1a.w, r1b.x, r1b.y, r1b.z, r1b.w};
#pragma unroll
                for (int e = 0; e < 8; ++e) {
                    *(LAS unsigned*)(KT + (seg * 16 + 2 * e) * TS + sp * 4) = pk2(bflo(x0[e]) * w0, bflo(x1[e]) * w1);
                    *(LAS unsigned*)(KT + (seg * 16 + 2 * e + 1) * TS + sp * 4) = pk2(bfhi(x0[e]) * w0, bfhi(x1[e]) * w1); }
            }
        } else {
            const int k = tid & 127, tq = tid >> 7;
            float G[16], kc[16], qv[16];
            float run = 0.f;
#pragma unroll
            for (int i = 0; i < 16; ++i) { const int t = tq * 16 + i;
                const float x = bf1(*(const LAS unsigned short*)(Kr + t * QS + k * 2));
                qv[i] = bf1(*(const LAS unsigned short*)(Q + t * QS + k * 2));
                const float sp_ = __builtin_amdgcn_rcpf(1.f + __expf(-x)), sm_ = __builtin_amdgcn_rcpf(1.f + __expf(x));
                const float f = lbk + (1.f - lbk) * sp_;
                kc[i] = (1.f - lbk) * sm_;
                run += __logf(f); G[i] = run; }
            SM[tq * 128 + k] = run;
            __syncthreads();
            const float t0 = SM[k], t1 = SM[128 + k], t2 = SM[256 + k], t3 = SM[384 + k];
            const float pre = (tq > 0 ? t0 : 0.f) + (tq > 1 ? t1 : 0.f) + (tq > 2 ? t2 : 0.f);
            const float Gend = (t0 + t1) + (t2 + t3);
            if (tq == 0) SM[512 + k] = __expf(Gend);
            unsigned kt[8];
#pragma unroll
            for (int i = 0; i < 16; i += 2) {
                const float d0 = Gend - (pre + G[i]), d1 = Gend - (pre + G[i + 1]);
                const float kg0 = kc[i] * __expf(d0), kg1 = kc[i + 1] * __expf(d1);
                const float qg0 = qv[i] * __expf(-d0), qg1 = qv[i + 1] * __expf(-d1);
                const unsigned kp = pk2(kg0, kg1), qp = pk2(qg0, qg1);
                kt[i >> 1] = kp;
                *(LAS unsigned short*)(Kr + (tq * 16 + i) * QS + k * 2) = (unsigned short)(kp & 0xffffu);
                *(LAS unsigned short*)(Kr + (tq * 16 + i + 1) * QS + k * 2) = (unsigned short)(kp >> 16);
                *(LAS unsigned short*)(Q + (tq * 16 + i) * QS + k * 2) = (unsigned short)(qp & 0xffffu);
                *(LAS unsigned short*)(Q + (tq * 16 + i + 1) * QS + k * 2) = (unsigned short)(qp >> 16); }
            *(LAS u32x4*)(KT + k * TS + tq * 32) = (u32x4){kt[0], kt[1], kt[2], kt[3]};
            *(LAS u32x4*)(KT + k * TS + tq * 32 + 16) = (u32x4){kt[4], kt[5], kt[6], kt[7]};
        }
        if (!isden && tid < 256) { const int sp = tid & 31, seg = tid >> 5;
            const u32x4 r0a = *(const LAS u32x4*)(VR + (2 * sp) * VRS + seg * 32), r0b = *(const LAS u32x4*)(VR + (2 * sp) * VRS + seg * 32 + 16);
            const u32x4 r1a = *(const LAS u32x4*)(VR + (2 * sp + 1) * VRS + seg * 32), r1b = *(const LAS u32x4*)(VR + (2 * sp + 1) * VRS + seg * 32 + 16);
            const unsigned x0[8] = {r0a.x, r0a.y, r0a.z, r0a.w, r0b.x, r0b.y, r0b.z, r0b.w};
            const unsigned x1[8] = {r1a.x, r1a.y, r1a.z, r1a.w, r1b.x, r1b.y, r1b.z, r1b.w};
#pragma unroll
            for (int e = 0; e < 8; ++e) {
                *(LAS unsigned*)(VT + (seg * 16 + 2 * e) * TS + sp * 4) = (x0[e] & 0xffffu) | (x1[e] << 16);
                *(LAS unsigned*)(VT + (seg * 16 + 2 * e + 1) * TS + sp * 4) = (x0[e] >> 16) | (x1[e] & 0xffff0000u); }
        }
        if (!IS_ML) __syncthreads();
        { const int tr = w >> 1;
#pragma unroll
            for (int ti = 0; ti < 2; ++ti) { const int tc = (w & 1) * 2 + ti;
                f32x4 acc = (f32x4){0.f, 0.f, 0.f, 0.f};
                if (tc <= tr) {
#pragma unroll
                    for (int kk = 0; kk < DK / 32; ++kk) {
                        const bf16x8 A = *(const LAS bf16x8*)(Q + (tr * 16 + c16) * QS + (kk * 32 + g * 8) * 2);
                        const bf16x8 B = *(const LAS bf16x8*)(Kr + (tc * 16 + c16) * QS + (kk * 32 + g * 8) * 2);
                        acc = __builtin_amdgcn_mfma_f32_16x16x32_bf16(A, B, acc, 0, 0, 0); }
                }
                const int s = tc * 16 + c16;
                float as_ = 0.f; f32x4 Mv = (f32x4){0.f, 0.f, 0.f, 0.f};
                if (IS_ML) { as_ = SMW[s]; Mv = *(const LAS f32x4*)(SMW + 64 + tr * 16 + g * 4); }
#pragma unroll
                for (int j = 0; j < 4; ++j) { const int t = tr * 16 + g * 4 + j;
                    float v = acc[j];
                    if (IS_ML) { v = v * 0.0625f * __expf(fminf(as_ - Mv[j], 0.f)); }
                    v = (s <= t) ? v : 0.f;
                    *(LAS unsigned short*)(P + t * TS + s * 2) = (unsigned short)(pk2(v, 0.f) & 0xffffu); }
            }
        }
        __syncthreads();
        if (!isden || w == 0) {
            bf16x8 Bv[2];
            if (isden) { const short one = (c16 == 0) ? (short)0x3F80 : (short)0;
                Bv[0] = (bf16x8){one, one, one, one, one, one, one, one}; Bv[1] = Bv[0]; }
            else {
#pragma unroll
                for (int ks = 0; ks < 2; ++ks) Bv[ks] = *(const LAS bf16x8*)(VT + (w * 16 + c16) * TS + (ks * 32 + g * 8) * 2); }
            if (!IS_ML) {
#pragma unroll
                for (int rb = 0; rb < NRB; ++rb) { const f32x4 dv = *(const LAS f32x4*)(SM + 512 + rb * 16 + g * 4); S[rb] = S[rb] * dv; } }
            f32x4 o2[4];
#pragma unroll
            for (int tt = 0; tt < 4; ++tt) o2[tt] = (f32x4){0.f, 0.f, 0.f, 0.f};
#pragma unroll
            for (int i = 0; i < NRB / 2; ++i) {
                const unsigned b0 = pk2(S[2 * i][0], S[2 * i][1]), b1 = pk2(S[2 * i][2], S[2 * i][3]), b2 = pk2(S[2 * i + 1][0], S[2 * i + 1][1]), b3 = pk2(S[2 * i + 1][2], S[2 * i + 1][3]);
                const u32x4 bu = (u32x4){b0, b1, b2, b3};
                const bf16x8 Bs = __builtin_bit_cast(bf16x8, bu);
#pragma unroll
                for (int tt = 0; tt < 4; ++tt) {
                    const u32x2 a0 = *(const LAS u32x2*)(Q + (tt * 16 + c16) * QS + ((2 * i) * 16 + g * 4) * 2);
                    const u32x2 a1 = *(const LAS u32x2*)(Q + (tt * 16 + c16) * QS + ((2 * i + 1) * 16 + g * 4) * 2);
                    const u32x4 au = (u32x4){a0.x, a0.y, a1.x, a1.y};
                    o2[tt] = __builtin_amdgcn_mfma_f32_16x16x32_bf16(__builtin_bit_cast(bf16x8, au), Bs, o2[tt], 0, 0, 0); }
                if ((i & 1) == 1) __builtin_amdgcn_sched_barrier(0);
            }
            if (IS_ML) {
#pragma unroll
                for (int tt = 0; tt < 4; ++tt) o2[tt] = o2[tt] * *(const LAS f32x4*)(SMW + 128 + tt * 16 + g * 4); }
#pragma unroll
            for (int tt = 0; tt < 4; ++tt) {
#pragma unroll
                for (int ks = 0; ks < 2; ++ks) { const bf16x8 A = *(const LAS bf16x8*)(P + (tt * 16 + c16) * TS + (ks * 32 + g * 8) * 2);
                    o2[tt] = __builtin_amdgcn_mfma_f32_16x16x32_bf16(A, Bv[ks], o2[tt], 0, 0, 0); } }
#pragma unroll
            for (int tt = 0; tt < 4; ++tt)
#pragma unroll
                for (int j = 0; j < 4; ++j) { const int t = tt * 16 + g * 4 + j;
                    const float v = o2[tt][j];
                    const size_t tok = tok0 + c * 64 + t;
                    if (isden) { const float mtt = SMW[192 + t];
                        if (c16 == 0) { ((float*)(p.ws + WS_DEN))[tok * 4 + h] = v; ((float*)(p.ws + WS_MT))[tok * 4 + h] = mtt; } }
                    else OUT[tok * D + ocol] = v; }
            __builtin_amdgcn_sched_barrier(0);
#pragma unroll
            for (int rb = 0; rb < NRB; ++rb) {
                f32x4 acc = IS_ML ? S[rb] * decay : S[rb];
#pragma unroll
                for (int ks = 0; ks < 2; ++ks) { const bf16x8 A = *(const LAS bf16x8*)(KT + (rb * 16 + c16) * TS + (ks * 32 + g * 8) * 2);
                    acc = __builtin_amdgcn_mfma_f32_16x16x32_bf16(A, Bv[ks], acc, 0, 0, 0); }
                S[rb] = acc;
                if ((rb & 3) == 3) __builtin_amdgcn_sched_barrier(0); }
        }
        m_prev = m_new;
        __syncthreads();
    }
    if (IS_ML) {
        if (!isden) { float* Co = p.out + O_CP + (size_t)bh * 256 * 512 + sl * 128 + w * 16 + c16;
#pragma unroll
            for (int rb = 0; rb < NRB; ++rb)
#pragma unroll
                for (int j = 0; j < 4; ++j) Co[(size_t)(rb * 16 + g * 4 + j) * 512] = S[rb][j]; }
        else if (w == 0) {
            if (c16 == 0) {
#pragma unroll
                for (int rb = 0; rb < NRB; ++rb)
#pragma unroll
                    for (int j = 0; j < 4; ++j) p.out[O_NP + (size_t)bh * 256 + rb * 16 + g * 4 + j] = S[rb][j]; }
            if (lane == 0) p.out[O_MP + bh] = m_prev; }
    } else {
        float* So = p.out + O_SP + (size_t)bh * 128 * 256 + sl * 128 + w * 16 + c16;
#pragma unroll
        for (int rb = 0; rb < NRB; ++rb)
#pragma unroll
            for (int j = 0; j < 4; ++j) So[(size_t)(rb * 16 + g * 4 + j) * 256] = S[rb][j];
    }
}

template <bool IS_ML>
__device__ __forceinline__ void stream_item(const Params& p, LAS unsigned char* lds, int bh) {
    constexpr int K = IS_ML ? 256 : 128, V = IS_ML ? 512 : 256, NH = IS_ML ? 4 : 8;
    constexpr int CG = V / 4, RG = 512 / CG, NR = K / RG, U = 8;
    constexpr int OFF_A = 0, OFF_B = OFF_A + K * 64, OFF_DEC = OFF_B + K * 64, OFF_VV = OFF_DEC + K * 4, OFF_PP = OFF_VV + 8 * V * 4, OFF_PART = OFF_PP + 256, OFF_QN = OFF_PART + 2048, OFF_RED = OFF_QN + 256;
    static_assert(OFF_RED + RG * 8 * V * 4 <= LDS_BYTES, "stream LDS");
    LAS float* A16 = (LAS float*)(lds + OFF_A); LAS float* B16 = (LAS float*)(lds + OFF_B); LAS float* DEC = (LAS float*)(lds + OFF_DEC);
    LAS float* VV = (LAS float*)(lds + OFF_VV); LAS float* PP = (LAS float*)(lds + OFF_PP); LAS float* PART = (LAS float*)(lds + OFF_PART);
    LAS float* QN = (LAS float*)(lds + OFF_QN); LAS float* RED = (LAS float*)(lds + OFF_RED);
    const int tid = threadIdx.x, lane = tid & 63, w = tid >> 6;
    const int b = bh / NH, h = bh % NH;
    const size_t tok0 = (size_t)NTP + (size_t)b * 8;
    const bf16_t* proj = (const bf16_t*)(p.ws + WS_PROJ);
    float wint[8], a_[8], M_[8], mt[8]; float decay = 1.f, m_new = 0.f;
#pragma unroll
    for (int t = 0; t < 8; ++t) { wint[t] = 1.f; a_[t] = 0.f; M_[t] = 0.f; mt[t] = 0.f; }
    if (IS_ML) {
        const float* GATES = (const float*)(p.ws + WS_GATES);
        const float m0 = p.m0[bh];
        float bt = 0.f, cm = -3.0e38f, wend[8];
#pragma unroll
        for (int t = 0; t < 8; ++t) { const float ig = GATES[(tok0 + t) * 8 + h], lf = GATES[(tok0 + t) * 8 + 4 + h];
            bt += lf; a_[t] = ig - bt; cm = fmaxf(cm, a_[t]); M_[t] = fmaxf(m0, cm); mt[t] = bt + M_[t]; wint[t] = __expf(m0 - M_[t]); }
        const float M_end = M_[7];
        decay = __expf(m0 - M_end); m_new = bt + M_end;
#pragma unroll
        for (int t = 0; t < 8; ++t) wend[t] = __expf(a_[t] - M_end);
        { const int t = tid >> 6, k4 = (tid & 63) * 4;
            const u32x2 qv = *(const u32x2*)(proj + (tok0 + t) * NP + C_MLQ + h * 256 + k4), kv = *(const u32x2*)(proj + (tok0 + t) * NP + C_MLK + h * 256 + k4);
            const float qf[4] = {bflo(qv.x), bfhi(qv.x), bflo(qv.y), bfhi(qv.y)};
            const float kf[4] = {bflo(kv.x) * 0.0625f, bfhi(kv.x) * 0.0625f, bflo(kv.y) * 0.0625f, bfhi(kv.y) * 0.0625f};
            float we = wend[0];
#pragma unroll
            for (int u = 1; u < 8; ++u) we = (t == u) ? wend[u] : we;
#pragma unroll
            for (int e = 0; e < 4; ++e) { A16[(k4 + e) * 16 + t] = qf[e]; A16[(k4 + e) * 16 + 8 + t] = kf[e] * we; B16[(k4 + e) * 16 + t] = qf[e]; B16[(k4 + e) * 16 + 8 + t] = kf[e]; } }
        { const int t = tid >> 6, c8 = (tid & 63) * 8;
            const u32x4 vv = *(const u32x4*)(proj + (tok0 + t) * NP + C_MLV + h * 512 + c8);
            *(LAS f32x4*)(VV + t * V + c8) = (f32x4){bflo(vv.x), bfhi(vv.x), bflo(vv.y), bfhi(vv.y)};
            *(LAS f32x4*)(VV + t * V + c8 + 4) = (f32x4){bflo(vv.z), bfhi(vv.z), bflo(vv.w), bfhi(vv.w)}; }
    } else {
        if (tid < 128) { const int k = tid;
            const float lbk = sigmoidf_(p.lbl[h * 128 + k] - p.lbl[1024 + h * 128 + k]);
            float G[8], kc[8], qv[8]; float run = 0.f;
#pragma unroll
            for (int t = 0; t < 8; ++t) { const float x = bf1(proj[(tok0 + t) * NP + C_HGF + h * 128 + k]); qv[t] = bf1(proj[(tok0 + t) * NP + C_HGQ + h * 128 + k]);
                const float sp_ = __builtin_amdgcn_rcpf(1.f + __expf(-x)), sm_ = __builtin_amdgcn_rcpf(1.f + __expf(x));
                const float f = lbk + (1.f - lbk) * sp_; kc[t] = (1.f - lbk) * sm_; run += __logf(f); G[t] = run; }
            const float dec = __expf(run);
            DEC[k] = dec;
#pragma unroll
            for (int t = 0; t < 8; ++t) { const float e = __expf(run - G[t]), kw = kc[t] * e, qg = qv[t] * __expf(G[t] - run);
                A16[k * 16 + t] = qg * dec; A16[k * 16 + 8 + t] = kw; B16[k * 16 + t] = qg; B16[k * 16 + 8 + t] = kw; } }
        { const int t = tid >> 6, c4 = (tid & 63) * 4;
            const u32x2 vv = *(const u32x2*)(proj + (tok0 + t) * NP + C_HGI + h * 256 + c4);
            *(LAS f32x4*)(VV + t * V + c4) = (f32x4){bflo(vv.x), bfhi(vv.x), bflo(vv.y), bfhi(vv.y)}; }
    }
    __syncthreads();
    { const int pair = tid & 63, t = pair >> 3, s = pair & 7, part = tid >> 6; float acc = 0.f;
#pragma unroll 8
        for (int k = part * (K / 8); k < (part + 1) * (K / 8); ++k) acc += B16[k * 16 + t] * B16[k * 16 + 8 + s];
        PART[part * 64 + pair] = acc; }
    if (IS_ML && tid < 256) { const int dk = tid; const float n0v = p.n0[(size_t)bh * 256 + dk];
        float nn = decay * n0v;
#pragma unroll
        for (int s = 0; s < 8; ++s) nn += A16[dk * 16 + 8 + s];
        p.out[O_NS + (size_t)bh * 256 + dk] = nn;
#pragma unroll
        for (int t = 0; t < 8; ++t) { const float pr = wave_sum(A16[dk * 16 + t] * n0v); if (lane == 0) QN[w * 8 + t] = pr; } }
    __syncthreads();
    if (tid < 64) { const int t = tid >> 3, s = tid & 7; float v = 0.f;
#pragma unroll
        for (int q = 0; q < 8; ++q) v += PART[q * 64 + tid];
        if (IS_ML) { float as_ = a_[0], Mt = M_[0];
#pragma unroll
            for (int u = 1; u < 8; ++u) { as_ = (s == u) ? a_[u] : as_; Mt = (t == u) ? M_[u] : Mt; }
            v *= __expf(fminf(as_ - Mt, 0.f)); }
        PP[tid] = (s <= t) ? v : 0.f; }
    __syncthreads();
    if (IS_ML && tid < 8) { const int t = tid; float den = 0.f;
#pragma unroll
        for (int s = 0; s < 8; ++s) den += PP[t * 8 + s];
        float wi = wint[0], mtt = mt[0];
#pragma unroll
        for (int u = 1; u < 8; ++u) { wi = (t == u) ? wint[u] : wi; mtt = (t == u) ? mt[u] : mtt; }
        den += wi * ((QN[t] + QN[8 + t]) + (QN[16 + t] + QN[24 + t]));
        ((float*)(p.ws + WS_DEN))[(tok0 + t) * 4 + h] = den; ((float*)(p.ws + WS_MT))[(tok0 + t) * 4 + h] = mtt;
        if (t == 0) p.out[O_MS + bh] = m_new; }
    { const int cgid = tid % CG, rg = tid / CG, col = cgid * 4;
        const float* __restrict__ src = (IS_ML ? p.C0 : p.S0) + (size_t)bh * K * V + col;
        float* __restrict__ dst = p.out + (IS_ML ? O_CS : O_SS) + (size_t)bh * K * V + col;
        f32x4 acc[8], vv[8];
#pragma unroll
        for (int t = 0; t < 8; ++t) { acc[t] = (f32x4){0.f, 0.f, 0.f, 0.f}; vv[t] = *(const LAS f32x4*)(VV + t * V + col); }
        for (int r0 = 0; r0 < NR; r0 += U) {
            f32x4 cv[U];
#pragma unroll
            for (int u = 0; u < U; ++u) cv[u] = __builtin_nontemporal_load((const f32x4*)(src + (size_t)(rg + RG * (r0 + u)) * V));
#pragma unroll
            for (int u = 0; u < U; ++u) { const int k = rg + RG * (r0 + u);
                const f32x4 q0 = *(const LAS f32x4*)(A16 + k * 16), q1 = *(const LAS f32x4*)(A16 + k * 16 + 4), k0 = *(const LAS f32x4*)(A16 + k * 16 + 8), k1 = *(const LAS f32x4*)(A16 + k * 16 + 12);
                const float dec = IS_ML ? decay : DEC[k];
                f32x4 cn = cv[u] * dec;
#pragma unroll
                for (int t = 0; t < 4; ++t) { acc[t] += cv[u] * q0[t]; acc[4 + t] += cv[u] * q1[t]; cn += vv[t] * k0[t]; cn += vv[4 + t] * k1[t]; }
                __builtin_nontemporal_store(cn, (f32x4*)(dst + (size_t)k * V));
                __builtin_amdgcn_sched_barrier(0); }
        }
#pragma unroll
        for (int t = 0; t < 8; ++t) *(LAS f32x4*)(RED + (rg * 8 + t) * V + col) = acc[t];
    }
    __syncthreads();
    { float* OUT = (float*)(p.ws + (IS_ML ? WS_HA : WS_OB));
        for (int idx = tid; idx < 8 * CG; idx += 512) { const int t = idx / CG, col = (idx % CG) * 4;
            f32x4 sacc = (f32x4){0.f, 0.f, 0.f, 0.f};
#pragma unroll
            for (int r = 0; r < RG; ++r) sacc += *(const LAS f32x4*)(RED + (r * 8 + t) * V + col);
            if (IS_ML) { float wi = wint[0];
#pragma unroll
                for (int u = 1; u < 8; ++u) wi = (t == u) ? wint[u] : wi;
                sacc *= wi; }
#pragma unroll
            for (int s = 0; s < 8; ++s) sacc += *(const LAS f32x4*)(VV + s * V + col) * PP[t * 8 + s];
            *(f32x4*)(OUT + (tok0 + t) * D + h * V + col) = sacc; } }
    __syncthreads();
}

constexpr int N_ML_CHAIN = 80, N_HG_CHAIN = 64, N_ML_STREAM = 512, N_HG_STREAM = 1024;
constexpr int N_REC_ITEMS = N_ML_CHAIN + N_HG_CHAIN + N_ML_STREAM + N_HG_STREAM;
#ifndef RECMASK
#define RECMASK 15
#endif
__device__ __forceinline__ int queue_next(unsigned* ctr, LAS int* slot) {
    if (threadIdx.x == 0) *slot = (int)atomicAdd(ctr, 1u);
    __syncthreads();
    const int it = *slot;
    __syncthreads();
    return it;
}
__device__ __forceinline__ void phase_rec(const Params& p, LAS unsigned char* lds) {
    unsigned* ctr = (unsigned*)(p.ws + WS_CTL);
    LAS int* slot = (LAS int*)(lds + LDS_BYTES - 16);
    if (RECMASK & 1) for (;;) { const int it = queue_next(ctr + 0, slot); if (it >= N_ML_CHAIN) break; chain_item<true>(p, lds, it / 5, it % 5); }
    if (RECMASK & 2) for (;;) { const int it = queue_next(ctr + 1, slot); if (it >= N_HG_CHAIN) break; chain_item<false>(p, lds, it >> 1, it & 1); }
    if (RECMASK & 4) for (;;) { const int it = queue_next(ctr + 2, slot); if (it >= N_ML_STREAM) break; stream_item<true>(p, lds, it); }
    if (RECMASK & 8) for (;;) { const int it = queue_next(ctr + 3, slot); if (it >= N_HG_STREAM) break; stream_item<false>(p, lds, it); }
}

__device__ __forceinline__ void phase_branch(const Params& p) {
    const int lane = threadIdx.x & 63, gw = blockIdx.x * 8 + (threadIdx.x >> 6), NGW = gridDim.x * 8;
    const bf16_t* proj = (const bf16_t*)(p.ws + WS_PROJ);
    const float* HA = (const float*)(p.ws + WS_HA); const float* OB = (const float*)(p.ws + WS_OB);
    const float* DEN = (const float*)(p.ws + WS_DEN); const float* MT = (const float*)(p.ws + WS_MT);
    bf16_t* BRA = (bf16_t*)(p.ws + WS_BRA); bf16_t* BRB = (bf16_t*)(p.ws + WS_BRB);
    for (int row = gw; row < NT; row += NGW) {
#pragma unroll
        for (int h = 0; h < 4; ++h) {
            const float* hp = HA + (size_t)row * D + h * 512 + lane * 8;
            f32x4 v0 = *(const f32x4*)hp, v1 = *(const f32x4*)(hp + 4);
            const float den = DEN[(size_t)row * 4 + h], mtt = MT[(size_t)row * 4 + h];
            const float inv = 1.f / fmaxf(fabsf(den), expf(-mtt));
            v0 *= inv; v1 *= inv;
            const float mu = wave_sum((v0[0] + v0[1]) + (v0[2] + v0[3]) + (v1[0] + v1[1]) + (v1[2] + v1[3])) * (1.f / 512.f);
            v0 -= mu; v1 -= mu;
            const float var = wave_sum((v0[0] * v0[0] + v0[1] * v0[1]) + (v0[2] * v0[2] + v0[3] * v0[3]) + (v1[0] * v1[0] + v1[1] * v1[1]) + (v1[2] * v1[2] + v1[3] * v1[3])) * (1.f / 512.f);
            const float rstd = 1.f / sqrtf(var + LN_EPS);
            const f32x4 g0 = *(const f32x4*)(p.mlg + h * 512 + lane * 8), g1 = *(const f32x4*)(p.mlg + h * 512 + lane * 8 + 4);
            const u32x4 ov = *(const u32x4*)(proj + (size_t)row * NP + C_MLO + h * 512 + lane * 8);
            const float og[8] = {bflo(ov.x), bfhi(ov.x), bflo(ov.y), bfhi(ov.y), bflo(ov.z), bfhi(ov.z), bflo(ov.w), bfhi(ov.w)};
            float r[8];
#pragma unroll
            for (int e = 0; e < 4; ++e) { r[e] = v0[e] * rstd * g0[e] * sigmoidf_(og[e]); r[4 + e] = v1[e] * rstd * g1[e] * sigmoidf_(og[4 + e]); }
            u32x4 o; o.x = pk2(r[0], r[1]); o.y = pk2(r[2], r[3]); o.z = pk2(r[4], r[5]); o.w = pk2(r[6], r[7]);
            *(u32x4*)(BRA + (size_t)row * D + h * 512 + lane * 8) = o;
        }
#pragma unroll
        for (int h = 0; h < 8; ++h) {
            const f32x4 v = *(const f32x4*)(OB + (size_t)row * D + h * 256 + lane * 4);
            const float ms = wave_sum((v[0] * v[0] + v[1] * v[1]) + (v[2] * v[2] + v[3] * v[3])) * (1.f / 256.f);
            const float rstd = 1.f / sqrtf(ms + LN_EPS);
            const f32x4 g = *(const f32x4*)(p.hgg + h * 256 + lane * 4);
            const u32x2 gv = *(const u32x2*)(proj + (size_t)row * NP + C_HGG + h * 256 + lane * 4);
            const float gg[4] = {bflo(gv.x), bfhi(gv.x), bflo(gv.y), bfhi(gv.y)};
            float r[4];
#pragma unroll
            for (int e = 0; e < 4; ++e) r[e] = v[e] * rstd * g[e] * gg[e] * sigmoidf_(gg[e]);
            u32x2 o; o.x = pk2(r[0], r[1]); o.y = pk2(r[2], r[3]);
            *(u32x2*)(BRB + (size_t)row * D + h * 256 + lane * 4) = o;
        }
    }
}

template <bool WRITE_BF>
__device__ __forceinline__ void phase_ln(const float* Z, const float* gam, const float* bet, float* OF, bf16_t* OBF) {
    const int lane = threadIdx.x & 63, gw = blockIdx.x * 8 + (threadIdx.x >> 6), NGW = gridDim.x * 8;
    for (int row = gw; row < NT; row += NGW) {
        const f32x4* zr = (const f32x4*)(Z + (size_t)row * D);
        f32x4 v[8]; float s = 0.f;
#pragma unroll
        for (int j = 0; j < 8; ++j) { v[j] = zr[lane + 64 * j]; s += (v[j][0] + v[j][1]) + (v[j][2] + v[j][3]); }
        const float mu = wave_sum(s) * (1.f / D); float s2 = 0.f;
#pragma unroll
        for (int j = 0; j < 8; ++j) { v[j] -= mu; s2 += (v[j][0] * v[j][0] + v[j][1] * v[j][1]) + (v[j][2] * v[j][2] + v[j][3] * v[j][3]); }
        const float rstd = 1.f / sqrtf(wave_sum(s2) * (1.f / D) + LN_EPS);
#pragma unroll
        for (int j = 0; j < 8; ++j) { const f32x4 g = ((const f32x4*)gam)[lane + 64 * j], bb = ((const f32x4*)bet)[lane + 64 * j];
            const f32x4 o = v[j] * rstd * g + bb;
            ((f32x4*)(OF + (size_t)row * D))[lane + 64 * j] = o;
            if (WRITE_BF) { u32x2 ob; ob.x = pk2(o[0], o[1]); ob.y = pk2(o[2], o[3]); ((u32x2*)(OBF + (size_t)row * D))[lane + 64 * j] = ob; } }
    }
}

constexpr int N_PHASES = 10;
#ifndef PHMASK
#define PHMASK 1023
#endif
#define PH_BEGIN(k) if ((k) > p.ph_lo && (k) < p.ph_hi) grid.sync(); if ((PHMASK & (1 << (k))) && (k) >= p.ph_lo && (k) < p.ph_hi)
__global__ void __launch_bounds__(512, 2) mega(Params p) {
    extern __shared__ __attribute__((aligned(16))) unsigned char shm[];
    LAS unsigned char* lds = (LAS unsigned char*)shm;
    cg::grid_group grid = cg::this_grid();
    PH_BEGIN(0) phase_prep(p, lds);
    PH_BEGIN(1) { pg8::StaticOrder S; S.init(NT, NP, gridDim.x, blockIdx.x); pg8::Gemm g{(const bf16_t*)(p.ws + WS_XB), (const bf16_t*)(p.ws + WS_WIN), NT, NP, D};
        pg8::EpiProj E{(bf16_t*)(p.ws + WS_PROJ), NP}; pg8::gemm_phase(lds, g, S, E); }
    PH_BEGIN(2) phase_rec(p, lds);
    PH_BEGIN(3) phase_branch(p);
    PH_BEGIN(4) { pg8::StaticOrder S; S.init(NT, D, gridDim.x, blockIdx.x);
        { pg8::Gemm g{(const bf16_t*)(p.ws + WS_BRA), (const bf16_t*)(p.ws + WS_WA), NT, D, D};
            pg8::EpiMerge<0> E{(const bf16_t*)(p.ws + WS_PROJ), (float*)(p.ws + WS_TMP), (bf16_t*)(p.ws + WS_MRG)}; pg8::gemm_phase(lds, g, S, E); }
        __syncthreads();
        { pg8::Gemm g{(const bf16_t*)(p.ws + WS_BRB), (const bf16_t*)(p.ws + WS_WB), NT, D, D};
            pg8::EpiMerge<1> E{(const bf16_t*)(p.ws + WS_PROJ), (float*)(p.ws + WS_TMP), (bf16_t*)(p.ws + WS_MRG)}; pg8::gemm_phase(lds, g, S, E); } }
    PH_BEGIN(5) { pg8::StaticOrder S; S.init(NT, D, gridDim.x, blockIdx.x); pg8::Gemm g{(const bf16_t*)(p.ws + WS_MRG), (const bf16_t*)(p.ws + WS_WOUT), NT, D, D};
        pg8::EpiRes E{p.xp, p.xs, NTP, (float*)(p.ws + WS_Z1)}; pg8::gemm_phase(lds, g, S, E); }
    PH_BEGIN(6) phase_ln<true>((const float*)(p.ws + WS_Z1), p.ln1g, p.ln1b, (float*)(p.ws + WS_X1F), (bf16_t*)(p.ws + WS_X1B));
    PH_BEGIN(7) { pg8::StaticOrder S; S.init(NT, DFF, gridDim.x, blockIdx.x); pg8::Gemm g{(const bf16_t*)(p.ws + WS_X1B), (const bf16_t*)(p.ws + WS_WUP), NT, DFF, D};
        pg8::EpiHid E{(bf16_t*)(p.ws + WS_HID), DFF}; pg8::gemm_phase(lds, g, S, E); }
    PH_BEGIN(8) { pg8::StaticOrder S; S.init(NT, D, gridDim.x, blockIdx.x); pg8::Gemm g{(const bf16_t*)(p.ws + WS_HID), (const bf16_t*)(p.ws + WS_WDN), NT, D, DFF};
        pg8::EpiRes E{(const float*)(p.ws + WS_X1F), (const float*)(p.ws + WS_X1F), NT, (float*)(p.ws + WS_Z2)}; pg8::gemm_phase(lds, g, S, E); }
    PH_BEGIN(9) phase_ln<false>((const float*)(p.ws + WS_Z2), p.ln2g, p.ln2b, p.out + O_Y, nullptr);
}

#ifndef MK_MULTI
#define MK_MULTI 0
#endif
extern "C" void kernel_launch(void* const* d_in, const int* in_sizes, int n_in, void* d_out, int out_size, void* d_ws, size_t ws_size, hipStream_t stream) {
    static int grid = 0;
    if (grid == 0) {
        int dev = 0, cus = 0, per = 0;
        if (n_in != 21 || ws_size < WS_END) { fprintf(stderr, "kernel_launch: unexpected n_in %d / ws_size %zu (need %zu)\n", n_in, ws_size, (size_t)WS_END); grid = -1; return; }
        (void)hipGetDevice(&dev);
        (void)hipDeviceGetAttribute(&cus, hipDeviceAttributeMultiprocessorCount, dev);
        (void)hipFuncSetAttribute((const void*)mega, hipFuncAttributeMaxDynamicSharedMemorySize, LDS_BYTES);
        (void)hipOccupancyMaxActiveBlocksPerMultiprocessor(&per, (const void*)mega, 512, LDS_BYTES);
        if (per < 1) { fprintf(stderr, "kernel_launch: occupancy query says %d blocks per CU\n", per); per = 1; }
        grid = cus;
    }
    if (grid < 0) return;
    (void)hipMemsetAsync((char*)d_ws + WS_CTL, 0, 4096, stream);
    Params p{};
    const float** pp = (const float**)&p;
    for (int i = 0; i < 21; ++i) pp[i] = (const float*)d_in[i];
    p.out = (float*)d_out; p.ws = (unsigned char*)d_ws;
#if MK_MULTI
    for (int ph = 0; ph < N_PHASES; ++ph) { p.ph_lo = ph; p.ph_hi = ph + 1; hipLaunchKernelGGL(mega, dim3(grid), dim3(512), LDS_BYTES, stream, p); }
#else
    p.ph_lo = 0; p.ph_hi = N_PHASES;
    void* args[] = {&p};
    hipError_t e = hipLaunchCooperativeKernel((const void*)mega, dim3(grid), dim3(512), args, LDS_BYTES, stream);
    if (e != hipSuccess) fprintf(stderr, "kernel_launch: cooperative launch failed: %s (grid %d)\n", hipGetErrorString(e), grid);
#endif
}
```

```cpp
#include <hip/hip_runtime.h>
#include <hip/hip_cooperative_groups.h>
#include <cstdio>
#include <cstdint>
namespace cg = cooperative_groups;

#define LAS __attribute__((address_space(3)))
typedef unsigned short bf16_t;
typedef short bf16x8 __attribute__((ext_vector_type(8)));
typedef short bf16x4 __attribute__((ext_vector_type(4)));
typedef float f32x4 __attribute__((ext_vector_type(4)));
typedef float f32x2 __attribute__((ext_vector_type(2)));
typedef unsigned u32x4 __attribute__((ext_vector_type(4)));
typedef unsigned u32x2 __attribute__((ext_vector_type(2)));

constexpr int D = 2048, NTP = 8192, NTS = 1024, NT = 9216, DIN = 16392, NP = 16384, DFF = 8192;
constexpr int C_MLQ = 0, C_MLK = 1024, C_MLV = 2048, C_MLO = 4096, C_HGQ = 6144, C_HGF = 7168, C_HGI = 8192, C_HGG = 10240, C_GA = 12288, C_GB = 14336;
constexpr float LN_EPS = 1e-5f;
constexpr float ALPHA = 1.189207115002721f;
constexpr size_t O_Y = 0, O_CP = 18874368, O_NP = 20971520, O_MP = 20975616, O_SP = 20975632, O_CS = 22024208, O_NS = 89133072, O_MS = 89264144, O_SS = 89264656;
constexpr size_t WS_CTL = 0;
constexpr size_t WS_BAR = 4096;
constexpr size_t WS_WIN = 32768;
constexpr size_t WS_WA = WS_WIN + (size_t)NP * D * 2;
constexpr size_t WS_WB = WS_WA + (size_t)D * D * 2;
constexpr size_t WS_WOUT = WS_WB + (size_t)D * D * 2;
constexpr size_t WS_WUP = WS_WOUT + (size_t)D * D * 2;
constexpr size_t WS_WDN = WS_WUP + (size_t)DFF * D * 2;
constexpr size_t WS_XB = WS_WDN + (size_t)DFF * D * 2;
constexpr size_t WS_GATES = WS_XB + (size_t)NT * D * 2;
constexpr size_t WS_DEN = WS_GATES + (size_t)NT * 8 * 4;
constexpr size_t WS_MT = WS_DEN + (size_t)NT * 4 * 4;
constexpr size_t WS_PROJ = WS_MT + (size_t)NT * 4 * 4;
constexpr size_t WS_HA = WS_PROJ + (size_t)NT * NP * 2;
constexpr size_t WS_OB = WS_HA + (size_t)NT * D * 4;
constexpr size_t WS_BRA = WS_OB + (size_t)NT * D * 4;
constexpr size_t WS_BRB = WS_BRA + (size_t)NT * D * 2;
constexpr size_t WS_MRG = WS_BRB + (size_t)NT * D * 2;
constexpr size_t WS_PART = WS_MRG + (size_t)NT * D * 2;
constexpr size_t WS_END = WS_PART + (size_t)16 * NTS * D * 4;
constexpr size_t WS_TMP = WS_HA;
constexpr size_t WS_Z1 = WS_OB;
constexpr size_t WS_X1F = WS_PROJ;
constexpr size_t WS_X1B = WS_X1F + (size_t)NT * D * 4;
constexpr size_t WS_HID = WS_X1B + (size_t)NT * D * 2;
constexpr size_t WS_Z2 = WS_HA;
static_assert(WS_HID + (size_t)NT * DFF * 2 <= WS_HA, "overlay overflow");

constexpr int LDS_BYTES = 163840;

struct Params {
    const float *xp, *xs, *C0, *n0, *m0, *S0, *lbl, *w_in, *b_ig, *b_fg, *mlg, *hgg, *w_a, *w_b, *w_out, *ln1g, *ln1b, *w_up, *w_dn, *ln2g, *ln2b;
    float* out; unsigned char* ws;
    int ph_lo, ph_hi, rep, pad_;
};

__device__ __forceinline__ unsigned pk2(float lo, float hi) { unsigned r; asm("v_cvt_pk_bf16_f32 %0, %1, %2" : "=v"(r) : "v"(lo), "v"(hi)); return r; }
__device__ __forceinline__ float bflo(unsigned u) { return __uint_as_float(u << 16); }
__device__ __forceinline__ float bfhi(unsigned u) { return __uint_as_float(u & 0xffff0000u); }
__device__ __forceinline__ float bf1(unsigned short b) { return __uint_as_float(((unsigned)b) << 16); }
__device__ __forceinline__ float sigmoidf_(float x) { return __builtin_amdgcn_rcpf(1.f + __expf(-x)); }
__device__ __forceinline__ float wave_sum(float v) {
#pragma unroll
    for (int o = 1; o < 64; o <<= 1) v += __shfl_xor(v, o);
    return v;
}
#define LDS_WAIT() asm volatile("s_waitcnt lgkmcnt(0)" ::: "memory")
#define LDS_BAR() do { asm volatile("s_waitcnt lgkmcnt(0)" ::: "memory"); __builtin_amdgcn_s_barrier(); asm volatile("" ::: "memory"); } while (0)


#define XB_TMO      128
#define XB_XCNT(j)  (256  + 64 * (j))
#define XB_XSUB(j)  (1280 + 64 * (j))
#define XB_XGEN(j)  (2304 + 64 * (j))
#define XB_TOP      3328
#define XB_TOPGEN   3392
#define XCD_BAR_WORDS 3456
#define XB_SPIN_CAP (1u << 22)
__device__ __forceinline__ unsigned xb_ld(unsigned* p)              { return __hip_atomic_load(p, __ATOMIC_RELAXED, __HIP_MEMORY_SCOPE_AGENT); }
__device__ __forceinline__ unsigned xb_add(unsigned* p, unsigned v) { return __hip_atomic_fetch_add(p, v, __ATOMIC_RELAXED, __HIP_MEMORY_SCOPE_AGENT); }
__device__ __forceinline__ unsigned xb_xcc_id() { return (unsigned)__builtin_amdgcn_s_getreg((3 << 11) | 20) & 0xFu; }
#define XB_SPIN(cond, bar) do { unsigned _sp = 0; while (cond) { __builtin_amdgcn_s_sleep(1); \
    if ((++_sp & 255u) == 0u) { if (xb_ld(&(bar)[XB_TMO])) break; if (_sp > XB_SPIN_CAP) { atomicAdd(&(bar)[XB_TMO], 1u); break; } } } } while (0)
struct XcdBarrier { unsigned* bar; unsigned x; volatile LAS unsigned* st; };
__device__ __forceinline__ XcdBarrier xcd_barrier_post(unsigned* bar, volatile LAS unsigned* st) {
    XcdBarrier b; b.bar = bar; b.x = xb_xcc_id(); b.st = st;
    if (threadIdx.x == 0) (void)xb_add(&bar[XB_XCNT(b.x)], 1u);
    return b;
}
__device__ __forceinline__ void xcd_barrier_complete(unsigned* bar, unsigned x, unsigned& nloc, unsigned& nx) {
    const unsigned G = gridDim.x * gridDim.y * gridDim.z;
    unsigned sum, cnt, mine, sp = 0u;
    for (;;) {
        sum = 0u; cnt = 0u; mine = 0u;
#pragma unroll
        for (unsigned j = 0; j < 16; ++j) { const unsigned c = xb_ld(&bar[XB_XCNT(j)]); sum += c; cnt += (c > 0u) ? 1u : 0u; mine = (j == x) ? c : mine; }
        if (sum == G) break;
        __builtin_amdgcn_s_sleep(1);
        if ((++sp & 255u) == 0u) { if (xb_ld(&bar[XB_TMO])) break; if (sp > XB_SPIN_CAP) { atomicAdd(&bar[XB_TMO], 1u); break; } }
    }
    nloc = mine > 0u ? mine : 1u; nx = cnt > 0u ? cnt : 1u;
}
__device__ __forceinline__ void xcd_barrier(const XcdBarrier& b) {
    asm volatile("s_waitcnt vmcnt(0)" ::: "memory");
    __syncthreads();
    if (threadIdx.x == 0) {
        unsigned* bar = b.bar;
        __builtin_amdgcn_s_waitcnt(0);
        unsigned nloc = b.st[0], nx = b.st[1];
        if (nloc == 0u) { xcd_barrier_complete(bar, b.x, nloc, nx); b.st[0] = nloc; b.st[1] = nx; }
        const unsigned old = xb_add(&bar[XB_XSUB(b.x)], 1u);
        const unsigned gen = old / nloc;
        if (old + 1u == (gen + 1u) * nloc) {
            __builtin_amdgcn_fence(__ATOMIC_RELEASE, "agent");
            asm volatile("s_waitcnt vmcnt(0)" ::: "memory");
            const unsigned og = xb_add(&bar[XB_TOP], 1u);
            const unsigned tg = og / nx;
            if (og + 1u == (tg + 1u) * nx) xb_add(&bar[XB_TOPGEN], 1u);
            else XB_SPIN(xb_ld(&bar[XB_TOPGEN]) == tg, bar);
            __builtin_amdgcn_fence(__ATOMIC_ACQUIRE, "agent");
            xb_add(&bar[XB_XGEN(b.x)], 1u);
            asm volatile("s_waitcnt vmcnt(0)" ::: "memory");
        } else {
            XB_SPIN(xb_ld(&bar[XB_XGEN(b.x)]) == gen, bar);
            __builtin_amdgcn_fence(__ATOMIC_ACQUIRE, "agent");
            asm volatile("s_waitcnt vmcnt(0)" ::: "memory");
        }
    }
    __syncthreads();
}

namespace pg8 {
#define PG8_LAS __attribute__((address_space(3)))
constexpr int BM = 256, BK = 64, HALF = 128, HTB = HALF * BK * 2, STAGE_BYTES = 8 * HTB, NXCD = 8, WGM = 8;
__host__ __device__ __forceinline__ int lds_byte(int r, int c) { const int st = (r >> 4) * 2 + (c >> 5), rr = r & 15, cc = c & 31, ob = rr * 64 + cc * 2; return st * 1024 + (ob ^ (((ob >> 9) & 1) << 5)); }
__host__ __device__ __forceinline__ void stage_rc(int b, int& R, int& C) { const int st = b / 1024, sb = b % 1024, swz = sb ^ (((sb >> 9) & 1) << 5); R = (st >> 1) * 16 + swz / 64; C = (st & 1) * 32 + (swz % 64) / 2; }
__host__ __device__ __forceinline__ int perm32(int rho) { const int n = rho >> 4, i = rho & 15; return 8 * (i >> 2) + 4 * n + (i & 3); }
struct Unit { int pm, pn, k0, nt, mode; };
struct Gemm { const bf16_t* A; const bf16_t* Bt; int M, N, K; };
struct StaticOrder {
    int nM, nN, nwg, G, c, ntk;
    __host__ __device__ void init(int M, int N, int K, int G_, int c_) { nM = M / BM; nN = N / BM; nwg = nM * nN; G = G_; c = c_; ntk = K / BK; }
    __host__ __device__ void map(int wgid, Unit& u) const {
        { const int q = nwg / NXCD, r = nwg % NXCD, xcd = wgid % NXCD, off = wgid / NXCD; wgid = (xcd < r ? xcd * (q + 1) : r * (q + 1) + (xcd - r) * q) + off; }
        const int nig = WGM * nN, gid = wgid / nig, fm = gid * WGM, gsz = (nM - fm) < WGM ? (nM - fm) : WGM;
        u.pm = fm + ((wgid % nig) % gsz); u.pn = (wgid % nig) / gsz; u.k0 = 0; u.nt = ntk; u.mode = 0;
    }
    __host__ __device__ bool next(int i, Unit& u) const {
        const long L = (long)i * G + c; if (L >= nwg) return false;
        map((int)L, u); return true;
    }
    __device__ __forceinline__ void a_ready(const Unit&) const {}
    __device__ __forceinline__ void done(const Unit&) const {}
};
struct TailOrder : StaticOrder {
    int nsub, ksub;
    __host__ __device__ void init(int K, int G_, int c_) { StaticOrder::init(8192, 2048, K, G_, c_); nsub = 256; ksub = K / 8; }
    __host__ __device__ bool next(int i, Unit& u) const {
        const long L = (long)i * G + c;
        if (L < nwg) { map((int)L, u); return true; }
        const int j = (int)(L - nwg); if (j >= nsub) return false;
        const int uu = j >> 3, ks = j & 7;
        u.pm = 32 + (uu & 3); u.pn = uu >> 2; u.k0 = ks * ksub; u.nt = ksub / BK; u.mode = 1 + ks; return true;
    }
};
struct EpiProj {
    static constexpr bool PERM = true, AFTER_DRAIN = false;
    bf16_t* O; int ldc;
    __device__ __forceinline__ void operator()(const f32x4 (&acc)[2][2][4][2], const Unit& u, int wr, int wc, int fr, int fq) const {
        const int row0 = u.pm * BM + wr * 64 + fr, col0 = u.pn * BM + wc * 32 + 8 * fq;
#pragma unroll
        for (int ai = 0; ai < 2; ++ai)
#pragma unroll
            for (int m = 0; m < 4; ++m) { bf16_t* rowp = O + (size_t)(row0 + ai * HALF + m * 16) * ldc + col0;
#pragma unroll
                for (int bj = 0; bj < 2; ++bj) { const f32x4 v0 = acc[ai][bj][m][0], v1 = acc[ai][bj][m][1];
                    u32x4 o; o.x = pk2(v0[0], v0[1]); o.y = pk2(v0[2], v0[3]); o.z = pk2(v1[0], v1[1]); o.w = pk2(v1[2], v1[3]);
                    *(u32x4*)(rowp + bj * HALF) = o; } }
    }
};
struct EpiHid {
    static constexpr bool PERM = true, AFTER_DRAIN = false;
    bf16_t* O; int ldc;
    __device__ __forceinline__ void operator()(const f32x4 (&acc)[2][2][4][2], const Unit& u, int wr, int wc, int fr, int fq) const {
        const int row0 = u.pm * BM + wr * 64 + fr, col0 = u.pn * BM + wc * 32 + 8 * fq;
#pragma unroll
        for (int ai = 0; ai < 2; ++ai)
#pragma unroll
            for (int m = 0; m < 4; ++m) { bf16_t* rowp = O + (size_t)(row0 + ai * HALF + m * 16) * ldc + col0;
#pragma unroll
                for (int bj = 0; bj < 2; ++bj) { f32x4 v0 = acc[ai][bj][m][0], v1 = acc[ai][bj][m][1];
#pragma unroll
                    for (int e = 0; e < 4; ++e) { const float a = fmaxf(v0[e], 0.f), b = fmaxf(v1[e], 0.f); v0[e] = a * a; v1[e] = b * b; }
                    u32x4 o; o.x = pk2(v0[0], v0[1]); o.y = pk2(v0[2], v0[3]); o.z = pk2(v1[0], v1[1]); o.w = pk2(v1[2], v1[3]);
                    *(u32x4*)(rowp + bj * HALF) = o; } }
    }
};
template <int PASS> struct EpiMerge {
    static constexpr bool PERM = true, AFTER_DRAIN = false;
    const bf16_t* proj; float* tmp; bf16_t* O; float* tmpT;
    __device__ __forceinline__ void operator()(const f32x4 (&acc)[2][2][4][2], const Unit& u, int wr, int wc, int fr, int fq) const {
        const int row0 = u.pm * BM + wr * 64 + fr, col0 = u.pn * BM + wc * 32 + 8 * fq;
        const bool part = u.mode != 0;
#pragma unroll
        for (int ai = 0; ai < 2; ++ai)
#pragma unroll
            for (int m = 0; m < 4; ++m) { const size_t row = (size_t)(row0 + ai * HALF + m * 16);
#pragma unroll
                for (int bj = 0; bj < 2; ++bj) { const int col = col0 + bj * HALF;
                    const u32x4 gv = *(const u32x4*)(proj + row * NP + (PASS == 0 ? C_GA : C_GB) + col);
                    f32x4 s0, s1;
                    s0[0] = sigmoidf_(bflo(gv.x)); s0[1] = sigmoidf_(bfhi(gv.x)); s0[2] = sigmoidf_(bflo(gv.y)); s0[3] = sigmoidf_(bfhi(gv.y));
                    s1[0] = sigmoidf_(bflo(gv.z)); s1[1] = sigmoidf_(bfhi(gv.z)); s1[2] = sigmoidf_(bflo(gv.w)); s1[3] = sigmoidf_(bfhi(gv.w));
                    f32x4 v0 = acc[ai][bj][m][0] * s0, v1 = acc[ai][bj][m][1] * s1;
                    if (part) { float* tp = tmpT + ((size_t)(u.mode - 1 + 8 * PASS) * NTS + (row - NTP)) * D + col; *(f32x4*)tp = v0; *(f32x4*)(tp + 4) = v1; }
                    else { float* tp = tmp + row * D + col;
                        if (PASS == 0) { *(f32x4*)tp = v0; *(f32x4*)(tp + 4) = v1; }
                        else { v0 += *(const f32x4*)tp; v1 += *(const f32x4*)(tp + 4);
                            u32x4 o; o.x = pk2(v0[0], v0[1]); o.y = pk2(v0[2], v0[3]); o.z = pk2(v1[0], v1[1]); o.w = pk2(v1[2], v1[3]);
                            *(u32x4*)(O + row * D + col) = o; } }
                    __builtin_amdgcn_sched_barrier(0); } }
    }
};
struct EpiRes {
    static constexpr bool PERM = false, AFTER_DRAIN = false;
    const float* rA; const float* rB; int split; float* Z; float* PT;
    __device__ __forceinline__ void operator()(const f32x4 (&acc)[2][2][4][2], const Unit& u, int wr, int wc, int fr, int fq) const {
        const int row0 = u.pm * BM + wr * 64 + fr, col0 = u.pn * BM + wc * 32 + 4 * fq;
        const bool part = u.mode != 0;
#pragma unroll
        for (int ai = 0; ai < 2; ++ai)
#pragma unroll
            for (int m = 0; m < 4; ++m) { const int row = row0 + ai * HALF + m * 16;
                const float* rp = (row < split ? rA + (size_t)row * D : rB + (size_t)(row - split) * D) + col0;
                float* zp = Z + (size_t)row * D + col0;
#pragma unroll
                for (int bj = 0; bj < 2; ++bj)
#pragma unroll
                    for (int n = 0; n < 2; ++n) {
                        if (part) *(f32x4*)(PT + ((size_t)(u.mode - 1) * NTS + (row - NTP)) * D + col0 + bj * HALF + n * 16) = acc[ai][bj][m][n];
                        else { const f32x4 r = *(const f32x4*)(rp + bj * HALF + n * 16);
                            *(f32x4*)(zp + bj * HALF + n * 16) = r * ALPHA + acc[ai][bj][m][n]; } } }
    }
};

template <class Epi, class Sched>
__device__ __forceinline__ void gemm_phase(PG8_LAS unsigned char* lds, const Gemm g, const Sched& S, const Epi& E) {
    const int tid = threadIdx.x, wid = __builtin_amdgcn_readfirstlane(tid >> 6), lane = tid & 63, wr = wid >> 2, wc = wid & 3, fr = lane & 15, fq = lane >> 4;
    const int K = g.K;
    unsigned voffA[2], voffB[2];
#pragma unroll
    for (int i = 0; i < 2; ++i) { int R, C; stage_rc(tid * 16 + i * 8192, R, C); const int Rb = Epi::PERM ? ((R & ~31) + perm32(R & 31)) : R;
        voffA[i] = (unsigned)(R * K + C) * 2u; voffB[i] = (unsigned)(Rb * K + C) * 2u; }
    const size_t kstep = (size_t)(BK * 2);
    const size_t hstep = (size_t)HALF * K * 2;
    const size_t tstep = 2 * hstep;
    const unsigned ldsw = (unsigned)wid * 1024u;
    const int aoff = lds_byte(wr * 64 + fr, fq * 8), boff = lds_byte(wc * 32 + fr, fq * 8);
#define PG8_SA(b, h) (((b) * 2 + (h)) * HTB)
#define PG8_SB(b, h) ((4 + (b) * 2 + (h)) * HTB)
#define PG8_STAGE(bufoff, gbase, voff) do { _Pragma("unroll") for (int _i = 0; _i < 2; ++_i) \
        __builtin_amdgcn_global_load_lds((const unsigned*)((const char*)(gbase) + (voff)[_i]), (PG8_LAS unsigned*)(lds + (bufoff) + ldsw + _i * 8192), 16, 0, 0); } while (0)
#define PG8_LDA(dst, b, h) do { _Pragma("unroll") for (int m = 0; m < 4; ++m) _Pragma("unroll") for (int k = 0; k < 2; ++k) dst[m][k] = *(const PG8_LAS bf16x8*)(lds + PG8_SA(b, h) + aoff + m * 2048 + k * 1024); } while (0)
#define PG8_LDB(dst, b, h) do { _Pragma("unroll") for (int n = 0; n < 2; ++n) _Pragma("unroll") for (int k = 0; k < 2; ++k) dst[n][k] = *(const PG8_LAS bf16x8*)(lds + PG8_SB(b, h) + boff + n * 2048 + k * 1024); } while (0)
#define PG8_MMA(ai, bj, At, Bt) do { __builtin_amdgcn_s_setprio(1); _Pragma("unroll") for (int m = 0; m < 4; ++m) _Pragma("unroll") for (int n = 0; n < 2; ++n) _Pragma("unroll") for (int k = 0; k < 2; ++k) \
        acc[ai][bj][m][n] = __builtin_amdgcn_mfma_f32_16x16x32_bf16(Bt[n][k], At[m][k], acc[ai][bj][m][n], 0, 0, 0); __builtin_amdgcn_s_setprio(0); } while (0)
#define PG8_WAIT_V(n) asm volatile("s_waitcnt vmcnt(" #n ")" ::: "memory")
#define PG8_WAIT_L(n) asm volatile("s_waitcnt lgkmcnt(" #n ")" ::: "memory")
#define PG8_BAR __builtin_amdgcn_s_barrier()
#define PG8_SCHED __builtin_amdgcn_sched_barrier(0)
    Unit cur, nxt; int ui = 0;
    if (!S.next(0, cur)) return;
    f32x4 acc[2][2][4][2];
#pragma unroll
    for (int a = 0; a < 2; ++a)
#pragma unroll
        for (int b = 0; b < 2; ++b)
#pragma unroll
            for (int m = 0; m < 4; ++m)
#pragma unroll
                for (int n = 0; n < 2; ++n) acc[a][b][m][n] = (f32x4){0.f, 0.f, 0.f, 0.f};
    bf16x8 At[4][2], B0[2][2], B1[2][2];
    const char* cA = (const char*)g.A + (size_t)cur.pm * tstep + (size_t)cur.k0 * 2; const char* cB = (const char*)g.Bt + (size_t)cur.pn * tstep + (size_t)cur.k0 * 2;
    S.a_ready(cur);
    PG8_STAGE(PG8_SB(0, 0), cB, voffB); PG8_STAGE(PG8_SA(0, 0), cA, voffA); PG8_STAGE(PG8_SB(0, 1), cB + hstep, voffB); PG8_STAGE(PG8_SA(0, 1), cA + hstep, voffA);
    if (wr == 1) PG8_BAR;
    PG8_WAIT_V(4); PG8_BAR;
    PG8_STAGE(PG8_SB(1, 0), cB + kstep, voffB); PG8_STAGE(PG8_SA(1, 0), cA + kstep, voffA); PG8_STAGE(PG8_SB(1, 1), cB + hstep + kstep, voffB);
    PG8_WAIT_V(6); PG8_BAR;
    for (;;) {
        const bool has_next = S.next(ui + 1, nxt);
        const char* nA = has_next ? (const char*)g.A + (size_t)nxt.pm * tstep + (size_t)nxt.k0 * 2 : cA; const char* nB = has_next ? (const char*)g.Bt + (size_t)nxt.pn * tstep + (size_t)nxt.k0 * 2 : cB;
        const int nt = cur.nt;
        for (int t = 0; t < nt; t += 2) {
            const bool last = (t == nt - 2);
            const char* a1 = cA + (size_t)(t + 1) * kstep;
            const char* a2 = last ? nA : cA + (size_t)(t + 2) * kstep; const char* b2 = last ? nB : cB + (size_t)(t + 2) * kstep;
            const char* a3 = a2 + kstep; const char* b3 = b2 + kstep;
            if (last && has_next) S.a_ready(nxt);
            PG8_LDB(B0, 0, 0); PG8_SCHED; PG8_LDA(At, 0, 0); PG8_STAGE(PG8_SA(1, 1), a1 + hstep, voffA);
            PG8_WAIT_L(8); PG8_BAR; PG8_WAIT_L(0); PG8_MMA(0, 0, At, B0); PG8_BAR; PG8_SCHED;
            PG8_LDB(B1, 0, 1); PG8_STAGE(PG8_SB(0, 0), b2, voffB);
            PG8_BAR; PG8_WAIT_L(0); PG8_MMA(0, 1, At, B1); PG8_BAR;
            PG8_LDA(At, 0, 1); PG8_STAGE(PG8_SA(0, 0), a2, voffA);
            PG8_BAR; PG8_WAIT_L(0); PG8_MMA(1, 0, At, B0); PG8_BAR; PG8_SCHED;
            PG8_STAGE(PG8_SB(0, 1), b2 + hstep, voffB);
            PG8_WAIT_V(6); PG8_BAR; PG8_MMA(1, 1, At, B1); PG8_BAR;
            PG8_LDB(B0, 1, 0); PG8_SCHED; PG8_LDA(At, 1, 0); PG8_STAGE(PG8_SA(0, 1), a2 + hstep, voffA);
            PG8_WAIT_L(8); PG8_BAR; PG8_WAIT_L(0); PG8_MMA(0, 0, At, B0); PG8_BAR; PG8_SCHED;
            PG8_LDB(B1, 1, 1); PG8_STAGE(PG8_SB(1, 0), b3, voffB);
            PG8_BAR; PG8_WAIT_L(0); PG8_MMA(0, 1, At, B1); PG8_BAR;
            PG8_LDA(At, 1, 1); PG8_STAGE(PG8_SA(1, 0), a3, voffA);
            PG8_BAR; PG8_WAIT_L(0); PG8_MMA(1, 0, At, B0); PG8_BAR; PG8_SCHED;
            PG8_STAGE(PG8_SB(1, 1), b3 + hstep, voffB);
            PG8_WAIT_V(6); PG8_BAR; PG8_MMA(1, 1, At, B1); PG8_BAR;
        }
        if constexpr (!Epi::AFTER_DRAIN) { E(acc, cur, wr, wc, fr, fq); S.done(cur); }
        if (!has_next) break;
#pragma unroll
        for (int a = 0; a < 2; ++a)
#pragma unroll
            for (int b = 0; b < 2; ++b)
#pragma unroll
                for (int m = 0; m < 4; ++m)
#pragma unroll
                    for (int n = 0; n < 2; ++n) acc[a][b][m][n] = (f32x4){0.f, 0.f, 0.f, 0.f};
        cur = nxt; cA = nA; cB = nB; ++ui;
    }
    PG8_WAIT_V(0);
    if (wr == 0) PG8_BAR;
    PG8_BAR;
    if constexpr (Epi::AFTER_DRAIN) { E.fused(acc, cur, wr, wc, fr, fq, lds, wid, lane); S.done(cur); }
#undef PG8_SA
#undef PG8_SB
#undef PG8_STAGE
#undef PG8_LDA
#undef PG8_LDB
#undef PG8_MMA
#undef PG8_WAIT_V
#undef PG8_WAIT_L
#undef PG8_BAR
#undef PG8_SCHED
}
}

__device__ __forceinline__ void transpose_item(const float* __restrict__ W, int src_ld, int src_col, bf16_t* __restrict__ WT, int K, int dst_row, int k0, LAS float* scr, int lane) {
    const int kr = lane >> 4, n4 = (lane & 15) * 4;
    f32x4 v[16];
#pragma unroll
    for (int i = 0; i < 16; ++i) v[i] = __builtin_nontemporal_load((const f32x4*)(W + (size_t)(k0 + i * 4 + kr) * src_ld + src_col + n4));
#pragma unroll
    for (int i = 0; i < 16; ++i) { LAS float* s = scr + (i * 4 + kr) * 65 + n4; s[0] = v[i][0]; s[1] = v[i][1]; s[2] = v[i][2]; s[3] = v[i][3]; }
    LDS_WAIT();
    const int c = lane & 7, nn = lane >> 3;
#pragma unroll
    for (int j = 0; j < 8; ++j) { const int n = nn + 8 * j; const LAS float* s = scr + (8 * c) * 65 + n;
        u32x4 o; o.x = pk2(s[0 * 65], s[1 * 65]); o.y = pk2(s[2 * 65], s[3 * 65]); o.z = pk2(s[4 * 65], s[5 * 65]); o.w = pk2(s[6 * 65], s[7 * 65]);
        *(u32x4*)(WT + (size_t)(dst_row + n) * K + k0 + 8 * c) = o; }
    LDS_WAIT();
}
__device__ __forceinline__ float log_sigmoid_(float x) { return fminf(x, 0.f) - log1pf(expf(-fabsf(x))); }

__device__ __forceinline__ void phase_prep(const Params& p, LAS unsigned char* lds) {
    const int tid = threadIdx.x, lane = tid & 63, wave = tid >> 6;
    LAS float* wg = (LAS float*)lds;
    LAS float* scr = (LAS float*)(lds + wave * 16640);
    bf16_t* WIN = (bf16_t*)(p.ws + WS_WIN); bf16_t* WA = (bf16_t*)(p.ws + WS_WA); bf16_t* WB = (bf16_t*)(p.ws + WS_WB);
    bf16_t* WOUT = (bf16_t*)(p.ws + WS_WOUT); bf16_t* WUP = (bf16_t*)(p.ws + WS_WUP); bf16_t* WDN = (bf16_t*)(p.ws + WS_WDN);
    const int gw = blockIdx.x * 8 + wave, NGW = gridDim.x * 8;
    constexpr int I_IN = 32 * 256, I_SQ = 32 * 32, I_UP = 32 * 128, I_DN = 128 * 32, NITEMS = I_IN + 3 * I_SQ + I_UP + I_DN;
    for (int it = gw; it < NITEMS; it += NGW) {
        int r = it;
        if (r < I_IN) { const int kb = r >> 8, nb = r & 255, n0 = nb * 64; transpose_item(p.w_in, DIN, n0 + (n0 >= 4096 ? 8 : 0), WIN, D, n0, kb * 64, scr, lane); continue; } r -= I_IN;
        if (r < I_SQ) { const int kb = r >> 5, nb = r & 31; transpose_item(p.w_a, D, nb * 64, WA, D, nb * 64, kb * 64, scr, lane); continue; } r -= I_SQ;
        if (r < I_SQ) { const int kb = r >> 5, nb = r & 31; transpose_item(p.w_b, D, nb * 64, WB, D, nb * 64, kb * 64, scr, lane); continue; } r -= I_SQ;
        if (r < I_SQ) { const int kb = r >> 5, nb = r & 31; transpose_item(p.w_out, D, nb * 64, WOUT, D, nb * 64, kb * 64, scr, lane); continue; } r -= I_SQ;
        if (r < I_UP) { const int kb = r >> 7, nb = r & 127; transpose_item(p.w_up, DFF, nb * 64, WUP, D, nb * 64, kb * 64, scr, lane); continue; } r -= I_UP;
        { const int kb = r >> 5, nb = r & 31; transpose_item(p.w_dn, D, nb * 64, WDN, DFF, nb * 64, kb * 64, scr, lane); }
    }
    __syncthreads();
    for (int d = tid; d < D; d += 512) {
        const f32x4 a = *(const f32x4*)(p.w_in + (size_t)d * DIN + 4096), b = *(const f32x4*)(p.w_in + (size_t)d * DIN + 4100);
        *(LAS f32x4*)(wg + d * 8) = a; *(LAS f32x4*)(wg + d * 8 + 4) = b;
    }
    __syncthreads();
    bf16_t* XB = (bf16_t*)(p.ws + WS_XB); float* GATES = (float*)(p.ws + WS_GATES);
    for (int row = gw; row < NT; row += NGW) {
        const float* xr = row < NTP ? p.xp + (size_t)row * D : p.xs + (size_t)(row - NTP) * D;
        float gs[8];
#pragma unroll
        for (int e = 0; e < 8; ++e) gs[e] = 0.f;
#pragma unroll
        for (int j = 0; j < 8; ++j) {
            const f32x4 v = ((const f32x4*)xr)[lane + 64 * j];
            u32x2 o; o.x = pk2(v[0], v[1]); o.y = pk2(v[2], v[3]);
            ((u32x2*)(XB + (size_t)row * D))[lane + 64 * j] = o;
#pragma unroll
            for (int e = 0; e < 4; ++e) { const int d = 4 * (lane + 64 * j) + e;
                const f32x4 w0 = *(const LAS f32x4*)(wg + d * 8), w1 = *(const LAS f32x4*)(wg + d * 8 + 4);
#pragma unroll
                for (int q = 0; q < 4; ++q) { gs[q] += v[e] * w0[q]; gs[4 + q] += v[e] * w1[q]; } }
        }
#pragma unroll
        for (int e = 0; e < 8; ++e) gs[e] = wave_sum(gs[e]);
        if (lane < 4) { float gi = lane == 0 ? gs[0] : lane == 1 ? gs[1] : lane == 2 ? gs[2] : gs[3];
            float gf = lane == 0 ? gs[4] : lane == 1 ? gs[5] : lane == 2 ? gs[6] : gs[7];
            GATES[(size_t)row * 8 + lane] = gi + p.b_ig[lane];
            GATES[(size_t)row * 8 + 4 + lane] = log_sigmoid_(gf + p.b_fg[lane]); }
    }
}

template <bool IS_ML>
__device__ __forceinline__ void chain_item(const Params& p, LAS unsigned char* lds, int bh, int sl) {
    constexpr int DK = IS_ML ? 256 : 128, NPC = DK / 64, NRB = DK / 16;
    constexpr int QS = (DK + 8) * 2, TS = 144, VRS = 272;
    constexpr int OFF_Q = 0, OFF_K = OFF_Q + 64 * QS, OFF_KT = OFF_K + 64 * QS, OFF_VT = OFF_KT + DK * TS, OFF_VR = OFF_VT + 128 * TS, OFF_P = OFF_VR + 64 * VRS, OFF_SM = OFF_P + 64 * TS;
    static_assert(OFF_SM + 10240 + 16 <= LDS_BYTES, "chain LDS");
    const int tid = threadIdx.x, lane = tid & 63, w = tid >> 6, g = lane >> 4, c16 = lane & 15;
    const int b = IS_ML ? (bh >> 2) : (bh >> 3), h = IS_ML ? (bh & 3) : (bh & 7);
    const bool isden = IS_ML && sl == 4;
    const int qcol = IS_ML ? C_MLQ + h * 256 : C_HGQ + h * 128, kcol = IS_ML ? C_MLK + h * 256 : C_HGF + h * 128;
    const int vcol = IS_ML ? C_MLV + h * 512 + (isden ? 0 : sl) * 128 : C_HGI + h * 256 + sl * 128;
    const bf16_t* proj = (const bf16_t*)(p.ws + WS_PROJ);
    const float* GATES = (const float*)(p.ws + WS_GATES);
    const size_t tok0 = (size_t)b * 2048;
    LAS unsigned char* Q = lds + OFF_Q; LAS unsigned char* Kr = lds + OFF_K; LAS unsigned char* KT = lds + OFF_KT;
    LAS unsigned char* VT = lds + OFF_VT; LAS unsigned char* VR = lds + OFF_VR; LAS unsigned char* P = lds + OFF_P;
    LAS float* SM = (LAS float*)(lds + OFF_SM);
    LAS float* SMW = SM + w * 320;
    const int prow = tid >> 3, pseg = tid & 7;
    u32x4 pq[NPC], pk[NPC], pv[2]; float pig = 0.f, plf = 0.f;
    auto prefetch = [&](int c) {
        const bf16_t* rp = proj + (tok0 + c * 64 + prow) * NP;
#pragma unroll
        for (int i = 0; i < NPC; ++i) { pq[i] = *(const u32x4*)(rp + qcol + i * 64 + pseg * 8); pk[i] = *(const u32x4*)(rp + kcol + i * 64 + pseg * 8); }
        if (!isden) {
#pragma unroll
            for (int i = 0; i < 2; ++i) pv[i] = *(const u32x4*)(rp + vcol + i * 64 + pseg * 8); }
        if (IS_ML) { pig = GATES[(tok0 + c * 64 + lane) * 8 + h]; plf = GATES[(tok0 + c * 64 + lane) * 8 + 4 + h]; }
    };
    prefetch(0);
    f32x4 S[NRB];
#pragma unroll
    for (int i = 0; i < NRB; ++i) S[i] = (f32x4){0.f, 0.f, 0.f, 0.f};
    float m_prev = 0.f;
    float lbk = 0.f;
    if (!IS_ML) { const int k = tid & 127; lbk = sigmoidf_(p.lbl[h * 128 + k] - p.lbl[1024 + h * 128 + k]); }
    float* OUT = (float*)(p.ws + (IS_ML ? WS_HA : WS_OB));
    const int ocol = IS_ML ? h * 512 + sl * 128 + w * 16 + c16 : h * 256 + sl * 128 + w * 16 + c16;

    for (int c = 0; c < 32; ++c) {
#pragma unroll
        for (int i = 0; i < NPC; ++i) { *(LAS u32x4*)(Q + prow * QS + (i * 64 + pseg * 8) * 2) = pq[i]; *(LAS u32x4*)(Kr + prow * QS + (i * 64 + pseg * 8) * 2) = pk[i]; }
        if (!isden) {
#pragma unroll
            for (int i = 0; i < 2; ++i) *(LAS u32x4*)(VR + prow * VRS + (i * 64 + pseg * 8) * 2) = pv[i]; }
        const float ig = pig, lf = plf;
        if (c + 1 < 32) prefetch(c + 1);
        LDS_BAR();
        float a_t = 0.f, M_t = 0.f, wint = 1.f, mt = 0.f, decay = 1.f, m_new = 0.f;
        if (IS_ML) {
            float bt = lf;
#pragma unroll
            for (int o = 1; o < 64; o <<= 1) { const float y = __shfl_up(bt, o); if (lane >= o) bt += y; }
            a_t = ig - bt;
            float cm = a_t;
#pragma unroll
            for (int o = 1; o < 64; o <<= 1) { const float y = __shfl_up(cm, o); if (lane >= o) cm = fmaxf(cm, y); }
            M_t = fmaxf(m_prev, cm);
            const float M_end = __shfl(M_t, 63), b_end = __shfl(bt, 63);
            wint = __expf(m_prev - M_t); mt = bt + M_t;
            const float wend = __expf(a_t - M_end);
            decay = __expf(m_prev - M_end); m_new = b_end + M_end;
            SMW[lane] = a_t; SMW[64 + lane] = M_t; SMW[128 + lane] = wint; SMW[192 + lane] = mt; SMW[256 + lane] = wend;
            LDS_WAIT();
            { const int sp = tid & 31, seg = tid >> 5;
                const f32x2 wv = *(const LAS f32x2*)(SMW + 256 + 2 * sp); const float w0 = wv[0] * 0.0625f, w1 = wv[1] * 0.0625f;
                const u32x4 r0a = *(const LAS u32x4*)(Kr + (2 * sp) * QS + seg * 32), r0b = *(const LAS u32x4*)(Kr + (2 * sp) * QS + seg * 32 + 16);
                const u32x4 r1a = *(const LAS u32x4*)(Kr + (2 * sp + 1) * QS + seg * 32), r1b = *(const LAS u32x4*)(Kr + (2 * sp + 1) * QS + seg * 32 + 16);
                const unsigned x0[8] = {r0a.x, r0a.y, r0a.z, r0a.w, r0b.x, r0b.y, r0b.z, r0b.w};
                const unsigned x1[8] = {r1a.x, r1a.y, r1a.z, r1a.w, r1b.x, r1b.y, r1b.z, r1b.w};
#pragma unroll
                for (int e = 0; e < 8; ++e) {
                    *(LAS unsigned*)(KT + (seg * 16 + 2 * e) * TS + sp * 4) = pk2(bflo(x0[e]) * w0, bflo(x1[e]) * w1);
                    *(LAS unsigned*)(KT + (seg * 16 + 2 * e + 1) * TS + sp * 4) = pk2(bfhi(x0[e]) * w0, bfhi(x1[e]) * w1); }
            }
        } else {
            const int k = tid & 127, tq = tid >> 7;
            float G[16], kc[16], qv[16];
            float run = 0.f;
#pragma unroll
            for (int i = 0; i < 16; ++i) { const int t = tq * 16 + i;
                const float x = bf1(*(const LAS unsigned short*)(Kr + t * QS + k * 2));
                qv[i] = bf1(*(const LAS unsigned short*)(Q + t * QS + k * 2));
                const float sp_ = __builtin_amdgcn_rcpf(1.f + __expf(-x)), sm_ = __builtin_amdgcn_rcpf(1.f + __expf(x));
                const float f = lbk + (1.f - lbk) * sp_;
                kc[i] = (1.f - lbk) * sm_;
                run += __logf(f); G[i] = run; }
            SM[tq * 128 + k] = run;
            LDS_BAR();
            const float t0 = SM[k], t1 = SM[128 + k], t2 = SM[256 + k], t3 = SM[384 + k];
            const float pre = (tq > 0 ? t0 : 0.f) + (tq > 1 ? t1 : 0.f) + (tq > 2 ? t2 : 0.f);
            const float Gend = (t0 + t1) + (t2 + t3);
            if (tq == 0) SM[512 + k] = __expf(Gend);
            unsigned kt[8];
#pragma unroll
            for (int i = 0; i < 16; i += 2) {
                const float d0 = Gend - (pre + G[i]), d1 = Gend - (pre + G[i + 1]);
                const float kg0 = kc[i] * __expf(d0), kg1 = kc[i + 1] * __expf(d1);
                const float qg0 = qv[i] * __expf(-d0), qg1 = qv[i + 1] * __expf(-d1);
                const unsigned kp = pk2(kg0, kg1), qp = pk2(qg0, qg1);
                kt[i >> 1] = kp;
                *(LAS unsigned short*)(Kr + (tq * 16 + i) * QS + k * 2) = (unsigned short)(kp & 0xffffu);
                *(LAS unsigned short*)(Kr + (tq * 16 + i + 1) * QS + k * 2) = (unsigned short)(kp >> 16);
                *(LAS unsigned short*)(Q + (tq * 16 + i) * QS + k * 2) = (unsigned short)(qp & 0xffffu);
                *(LAS unsigned short*)(Q + (tq * 16 + i + 1) * QS + k * 2) = (unsigned short)(qp >> 16); }
            *(LAS u32x4*)(KT + k * TS + tq * 32) = (u32x4){kt[0], kt[1], kt[2], kt[3]};
            *(LAS u32x4*)(KT + k * TS + tq * 32 + 16) = (u32x4){kt[4], kt[5], kt[6], kt[7]};
        }
        if (!isden && tid < 256) { const int sp = tid & 31, seg = tid >> 5;
            const u32x4 r0a = *(const LAS u32x4*)(VR + (2 * sp) * VRS + seg * 32), r0b = *(const LAS u32x4*)(VR + (2 * sp) * VRS + seg * 32 + 16);
            const u32x4 r1a = *(const LAS u32x4*)(VR + (2 * sp + 1) * VRS + seg * 32), r1b = *(const LAS u32x4*)(VR + (2 * sp + 1) * VRS + seg * 32 + 16);
            const unsigned x0[8] = {r0a.x, r0a.y, r0a.z, r0a.w, r0b.x, r0b.y, r0b.z, r0b.w};
            const unsigned x1[8] = {r1a.x, r1a.y, r1a.z, r1a.w, r1b.x, r1b.y, r1b.z, r1b.w};
#pragma unroll
            for (int e = 0; e < 8; ++e) {
                *(LAS unsigned*)(VT + (seg * 16 + 2 * e) * TS + sp * 4) = (x0[e] & 0xffffu) | (x1[e] << 16);
                *(LAS unsigned*)(VT + (seg * 16 + 2 * e + 1) * TS + sp * 4) = (x0[e] >> 16) | (x1[e] & 0xffff0000u); }
        }
        if (!IS_ML) LDS_BAR();
        { const int tr = w >> 1;
#pragma unroll
            for (int ti = 0; ti < 2; ++ti) { const int tc = (w & 1) * 2 + ti;
                f32x4 acc = (f32x4){0.f, 0.f, 0.f, 0.f};
                if (tc <= tr) {
#pragma unroll
                    for (int kk = 0; kk < DK / 32; ++kk) {
                        const bf16x8 A = *(const LAS bf16x8*)(Q + (tr * 16 + c16) * QS + (kk * 32 + g * 8) * 2);
                        const bf16x8 B = *(const LAS bf16x8*)(Kr + (tc * 16 + c16) * QS + (kk * 32 + g * 8) * 2);
                        acc = __builtin_amdgcn_mfma_f32_16x16x32_bf16(A, B, acc, 0, 0, 0); }
                }
                const int s = tc * 16 + c16;
                float as_ = 0.f; f32x4 Mv = (f32x4){0.f, 0.f, 0.f, 0.f};
                if (IS_ML) { as_ = SMW[s]; Mv = *(const LAS f32x4*)(SMW + 64 + tr * 16 + g * 4); }
#pragma unroll
                for (int j = 0; j < 4; ++j) { const int t = tr * 16 + g * 4 + j;
                    float v = acc[j];
                    if (IS_ML) { v = v * 0.0625f * __expf(fminf(as_ - Mv[j], 0.f)); }
                    v = (s <= t) ? v : 0.f;
                    *(LAS unsigned short*)(P + t * TS + s * 2) = (unsigned short)(pk2(v, 0.f) & 0xffffu); }
            }
        }
        LDS_BAR();
        if (!isden || w == 0) {
            bf16x8 Bv[2];
            if (isden) { const short one = (c16 == 0) ? (short)0x3F80 : (short)0;
                Bv[0] = (bf16x8){one, one, one, one, one, one, one, one}; Bv[1] = Bv[0]; }
            else {
#pragma unroll
                for (int ks = 0; ks < 2; ++ks) Bv[ks] = *(const LAS bf16x8*)(VT + (w * 16 + c16) * TS + (ks * 32 + g * 8) * 2); }
            if (!IS_ML) {
#pragma unroll
                for (int rb = 0; rb < NRB; ++rb) { const f32x4 dv = *(const LAS f32x4*)(SM + 512 + rb * 16 + g * 4); S[rb] = S[rb] * dv; } }
            f32x4 o2[4];
#pragma unroll
            for (int tt = 0; tt < 4; ++tt) o2[tt] = (f32x4){0.f, 0.f, 0.f, 0.f};
#pragma unroll
            for (int i = 0; i < NRB / 2; ++i) {
                const unsigned b0 = pk2(S[2 * i][0], S[2 * i][1]), b1 = pk2(S[2 * i][2], S[2 * i][3]), b2 = pk2(S[2 * i + 1][0], S[2 * i + 1][1]), b3 = pk2(S[2 * i + 1][2], S[2 * i + 1][3]);
                const u32x4 bu = (u32x4){b0, b1, b2, b3};
                const bf16x8 Bs = __builtin_bit_cast(bf16x8, bu);
#pragma unroll
                for (int tt = 0; tt < 4; ++tt) {
                    const u32x2 a0 = *(const LAS u32x2*)(Q + (tt * 16 + c16) * QS + ((2 * i) * 16 + g * 4) * 2);
                    const u32x2 a1 = *(const LAS u32x2*)(Q + (tt * 16 + c16) * QS + ((2 * i + 1) * 16 + g * 4) * 2);
                    const u32x4 au = (u32x4){a0.x, a0.y, a1.x, a1.y};
                    o2[tt] = __builtin_amdgcn_mfma_f32_16x16x32_bf16(__builtin_bit_cast(bf16x8, au), Bs, o2[tt], 0, 0, 0); }
                if ((i & 1) == 1) __builtin_amdgcn_sched_barrier(0);
            }
            if (IS_ML) {
#pragma unroll
                for (int tt = 0; tt < 4; ++tt) o2[tt] = o2[tt] * *(const LAS f32x4*)(SMW + 128 + tt * 16 + g * 4); }
#pragma unroll
            for (int tt = 0; tt < 4; ++tt) {
#pragma unroll
                for (int ks = 0; ks < 2; ++ks) { const bf16x8 A = *(const LAS bf16x8*)(P + (tt * 16 + c16) * TS + (ks * 32 + g * 8) * 2);
                    o2[tt] = __builtin_amdgcn_mfma_f32_16x16x32_bf16(A, Bv[ks], o2[tt], 0, 0, 0); } }
#pragma unroll
            for (int tt = 0; tt < 4; ++tt)
#pragma unroll
                for (int j = 0; j < 4; ++j) { const int t = tt * 16 + g * 4 + j;
                    const float v = o2[tt][j];
                    const size_t tok = tok0 + c * 64 + t;
                    if (isden) { const float mtt = SMW[192 + t];
                        if (c16 == 0) { ((float*)(p.ws + WS_DEN))[tok * 4 + h] = v; ((float*)(p.ws + WS_MT))[tok * 4 + h] = mtt; } }
                    else OUT[tok * D + ocol] = v; }
            __builtin_amdgcn_sched_barrier(0);
#pragma unroll
            for (int rb = 0; rb < NRB; ++rb) {
                f32x4 acc = IS_ML ? S[rb] * decay : S[rb];
#pragma unroll
                for (int ks = 0; ks < 2; ++ks) { const bf16x8 A = *(const LAS bf16x8*)(KT + (rb * 16 + c16) * TS + (ks * 32 + g * 8) * 2);
                    acc = __builtin_amdgcn_mfma_f32_16x16x32_bf16(A, Bv[ks], acc, 0, 0, 0); }
                S[rb] = acc;
                if ((rb & 3) == 3) __builtin_amdgcn_sched_barrier(0); }
        }
        m_prev = m_new;
        LDS_BAR();
    }
    if (IS_ML) {
        if (!isden) { float* Co = p.out + O_CP + (size_t)bh * 256 * 512 + sl * 128 + w * 16 + c16;
#pragma unroll
            for (int rb = 0; rb < NRB; ++rb)
#pragma unroll
                for (int j = 0; j < 4; ++j) Co[(size_t)(rb * 16 + g * 4 + j) * 512] = S[rb][j]; }
        else if (w == 0) {
            if (c16 == 0) {
#pragma unroll
                for (int rb = 0; rb < NRB; ++rb)
#pragma unroll
                    for (int j = 0; j < 4; ++j) p.out[O_NP + (size_t)bh * 256 + rb * 16 + g * 4 + j] = S[rb][j]; }
            if (lane == 0) p.out[O_MP + bh] = m_prev; }
    } else {
        float* So = p.out + O_SP + (size_t)bh * 128 * 256 + sl * 128 + w * 16 + c16;
#pragma unroll
        for (int rb = 0; rb < NRB; ++rb)
#pragma unroll
            for (int j = 0; j < 4; ++j) So[(size_t)(rb * 16 + g * 4 + j) * 256] = S[rb][j];
    }
}

template <bool IS_ML>
__device__ __forceinline__ void stream_item(const Params& p, LAS unsigned char* lds, int bh) {
    constexpr int K = IS_ML ? 256 : 128, V = IS_ML ? 512 : 256, NH = IS_ML ? 4 : 8;
    constexpr int CG = V / 4, RG = 512 / CG, NR = K / RG, U = 8;
    constexpr int OFF_A = 0, OFF_B = OFF_A + K * 64, OFF_DEC = OFF_B + K * 64, OFF_VV = OFF_DEC + K * 4, OFF_PP = OFF_VV + 8 * V * 4, OFF_PART = OFF_PP + 256, OFF_QN = OFF_PART + 2048, OFF_RED = OFF_QN + 256;
    static_assert(OFF_RED + RG * 8 * V * 4 <= LDS_BYTES, "stream LDS");
    LAS float* A16 = (LAS float*)(lds + OFF_A); LAS float* B16 = (LAS float*)(lds + OFF_B); LAS float* DEC = (LAS float*)(lds + OFF_DEC);
    LAS float* VV = (LAS float*)(lds + OFF_VV); LAS float* PP = (LAS float*)(lds + OFF_PP); LAS float* PART = (LAS float*)(lds + OFF_PART);
    LAS float* QN = (LAS float*)(lds + OFF_QN); LAS float* RED = (LAS float*)(lds + OFF_RED);
    const int tid = threadIdx.x, lane = tid & 63, w = tid >> 6;
    const int b = bh / NH, h = bh % NH;
    const size_t tok0 = (size_t)NTP + (size_t)b * 8;
    const bf16_t* proj = (const bf16_t*)(p.ws + WS_PROJ);
    float wint[8], a_[8], M_[8], mt[8]; float decay = 1.f, m_new = 0.f;
#pragma unroll
    for (int t = 0; t < 8; ++t) { wint[t] = 1.f; a_[t] = 0.f; M_[t] = 0.f; mt[t] = 0.f; }
    if (IS_ML) {
        const float* GATES = (const float*)(p.ws + WS_GATES);
        const float m0 = p.m0[bh];
        float bt = 0.f, cm = -3.0e38f, wend[8];
#pragma unroll
        for (int t = 0; t < 8; ++t) { const float ig = GATES[(tok0 + t) * 8 + h], lf = GATES[(tok0 + t) * 8 + 4 + h];
            bt += lf; a_[t] = ig - bt; cm = fmaxf(cm, a_[t]); M_[t] = fmaxf(m0, cm); mt[t] = bt + M_[t]; wint[t] = __expf(m0 - M_[t]); }
        const float M_end = M_[7];
        decay = __expf(m0 - M_end); m_new = bt + M_end;
#pragma unroll
        for (int t = 0; t < 8; ++t) wend[t] = __expf(a_[t] - M_end);
        { const int t = tid >> 6, k4 = (tid & 63) * 4;
            const u32x2 qv = *(const u32x2*)(proj + (tok0 + t) * NP + C_MLQ + h * 256 + k4), kv = *(const u32x2*)(proj + (tok0 + t) * NP + C_MLK + h * 256 + k4);
            const float qf[4] = {bflo(qv.x), bfhi(qv.x), bflo(qv.y), bfhi(qv.y)};
            const float kf[4] = {bflo(kv.x) * 0.0625f, bfhi(kv.x) * 0.0625f, bflo(kv.y) * 0.0625f, bfhi(kv.y) * 0.0625f};
            float we = wend[0];
#pragma unroll
            for (int u = 1; u < 8; ++u) we = (t == u) ? wend[u] : we;
#pragma unroll
            for (int e = 0; e < 4; ++e) { A16[(k4 + e) * 16 + t] = qf[e]; A16[(k4 + e) * 16 + 8 + t] = kf[e] * we; B16[(k4 + e) * 16 + t] = qf[e]; B16[(k4 + e) * 16 + 8 + t] = kf[e]; } }
        { const int t = tid >> 6, c8 = (tid & 63) * 8;
            const u32x4 vv = *(const u32x4*)(proj + (tok0 + t) * NP + C_MLV + h * 512 + c8);
            *(LAS f32x4*)(VV + t * V + c8) = (f32x4){bflo(vv.x), bfhi(vv.x), bflo(vv.y), bfhi(vv.y)};
            *(LAS f32x4*)(VV + t * V + c8 + 4) = (f32x4){bflo(vv.z), bfhi(vv.z), bflo(vv.w), bfhi(vv.w)}; }
    } else {
        if (tid < 128) { const int k = tid;
            const float lbk = sigmoidf_(p.lbl[h * 128 + k] - p.lbl[1024 + h * 128 + k]);
            float G[8], kc[8], qv[8]; float run = 0.f;
#pragma unroll
            for (int t = 0; t < 8; ++t) { const float x = bf1(proj[(tok0 + t) * NP + C_HGF + h * 128 + k]); qv[t] = bf1(proj[(tok0 + t) * NP + C_HGQ + h * 128 + k]);
                const float sp_ = __builtin_amdgcn_rcpf(1.f + __expf(-x)), sm_ = __builtin_amdgcn_rcpf(1.f + __expf(x));
                const float f = lbk + (1.f - lbk) * sp_; kc[t] = (1.f - lbk) * sm_; run += __logf(f); G[t] = run; }
            const float dec = __expf(run);
            DEC[k] = dec;
#pragma unroll
            for (int t = 0; t < 8; ++t) { const float e = __expf(run - G[t]), kw = kc[t] * e, qg = qv[t] * __expf(G[t] - run);
                A16[k * 16 + t] = qg * dec; A16[k * 16 + 8 + t] = kw; B16[k * 16 + t] = qg; B16[k * 16 + 8 + t] = kw; } }
        { const int t = tid >> 6, c4 = (tid & 63) * 4;
            const u32x2 vv = *(const u32x2*)(proj + (tok0 + t) * NP + C_HGI + h * 256 + c4);
            *(LAS f32x4*)(VV + t * V + c4) = (f32x4){bflo(vv.x), bfhi(vv.x), bflo(vv.y), bfhi(vv.y)}; }
    }
    __syncthreads();
    { const int pair = tid & 63, t = pair >> 3, s = pair & 7, part = tid >> 6; float acc = 0.f;
#pragma unroll 8
        for (int k = part * (K / 8); k < (part + 1) * (K / 8); ++k) acc += B16[k * 16 + t] * B16[k * 16 + 8 + s];
        PART[part * 64 + pair] = acc; }
    if (IS_ML && tid < 256) { const int dk = tid; const float n0v = p.n0[(size_t)bh * 256 + dk];
        float nn = decay * n0v;
#pragma unroll
        for (int s = 0; s < 8; ++s) nn += A16[dk * 16 + 8 + s];
        p.out[O_NS + (size_t)bh * 256 + dk] = nn;
#pragma unroll
        for (int t = 0; t < 8; ++t) { const float pr = wave_sum(A16[dk * 16 + t] * n0v); if (lane == 0) QN[w * 8 + t] = pr; } }
    __syncthreads();
    if (tid < 64) { const int t = tid >> 3, s = tid & 7; float v = 0.f;
#pragma unroll
        for (int q = 0; q < 8; ++q) v += PART[q * 64 + tid];
        if (IS_ML) { float as_ = a_[0], Mt = M_[0];
#pragma unroll
            for (int u = 1; u < 8; ++u) { as_ = (s == u) ? a_[u] : as_; Mt = (t == u) ? M_[u] : Mt; }
            v *= __expf(fminf(as_ - Mt, 0.f)); }
        PP[tid] = (s <= t) ? v : 0.f; }
    __syncthreads();
    if (IS_ML && tid < 8) { const int t = tid; float den = 0.f;
#pragma unroll
        for (int s = 0; s < 8; ++s) den += PP[t * 8 + s];
        float wi = wint[0], mtt = mt[0];
#pragma unroll
        for (int u = 1; u < 8; ++u) { wi = (t == u) ? wint[u] : wi; mtt = (t == u) ? mt[u] : mtt; }
        den += wi * ((QN[t] + QN[8 + t]) + (QN[16 + t] + QN[24 + t]));
        ((float*)(p.ws + WS_DEN))[(tok0 + t) * 4 + h] = den; ((float*)(p.ws + WS_MT))[(tok0 + t) * 4 + h] = mtt;
        if (t == 0) p.out[O_MS + bh] = m_new; }
    { const int cgid = tid % CG, rg = tid / CG, col = cgid * 4;
        const float* __restrict__ src = (IS_ML ? p.C0 : p.S0) + (size_t)bh * K * V + col;
        float* __restrict__ dst = p.out + (IS_ML ? O_CS : O_SS) + (size_t)bh * K * V + col;
        f32x4 acc[8], vv[8];
#pragma unroll
        for (int t = 0; t < 8; ++t) { acc[t] = (f32x4){0.f, 0.f, 0.f, 0.f}; vv[t] = *(const LAS f32x4*)(VV + t * V + col); }
        for (int r0 = 0; r0 < NR; r0 += U) {
            f32x4 cv[U];
#pragma unroll
            for (int u = 0; u < U; ++u) cv[u] = __builtin_nontemporal_load((const f32x4*)(src + (size_t)(rg + RG * (r0 + u)) * V));
#pragma unroll
            for (int u = 0; u < U; ++u) { const int k = rg + RG * (r0 + u);
                const f32x4 q0 = *(const LAS f32x4*)(A16 + k * 16), q1 = *(const LAS f32x4*)(A16 + k * 16 + 4), k0 = *(const LAS f32x4*)(A16 + k * 16 + 8), k1 = *(const LAS f32x4*)(A16 + k * 16 + 12);
                const float dec = IS_ML ? decay : DEC[k];
                f32x4 cn = cv[u] * dec;
#pragma unroll
                for (int t = 0; t < 4; ++t) { acc[t] += cv[u] * q0[t]; acc[4 + t] += cv[u] * q1[t]; cn += vv[t] * k0[t]; cn += vv[4 + t] * k1[t]; }
                __builtin_nontemporal_store(cn, (f32x4*)(dst + (size_t)k * V));
                __builtin_amdgcn_sched_barrier(0); }
        }
#pragma unroll
        for (int t = 0; t < 8; ++t) *(LAS f32x4*)(RED + (rg * 8 + t) * V + col) = acc[t];
    }
    __syncthreads();
    { float* OUT = (float*)(p.ws + (IS_ML ? WS_HA : WS_OB));
        for (int idx = tid; idx < 8 * CG; idx += 512) { const int t = idx / CG, col = (idx % CG) * 4;
            f32x4 sacc = (f32x4){0.f, 0.f, 0.f, 0.f};
#pragma unroll
            for (int r = 0; r < RG; ++r) sacc += *(const LAS f32x4*)(RED + (r * 8 + t) * V + col);
            if (IS_ML) { float wi = wint[0];
#pragma unroll
                for (int u = 1; u < 8; ++u) wi = (t == u) ? wint[u] : wi;
                sacc *= wi; }
#pragma unroll
            for (int s = 0; s < 8; ++s) sacc += *(const LAS f32x4*)(VV + s * V + col) * PP[t * 8 + s];
            *(f32x4*)(OUT + (tok0 + t) * D + h * V + col) = sacc; } }
    __syncthreads();
}

constexpr int N_ML_CHAIN = 80, N_HG_CHAIN = 64, N_ML_STREAM = 512, N_HG_STREAM = 1024;
constexpr int N_REC_ITEMS = N_ML_CHAIN + N_HG_CHAIN + N_ML_STREAM + N_HG_STREAM;
#ifndef RECMASK
#define RECMASK 15
#endif
__device__ __forceinline__ int queue_next(unsigned* ctr, LAS int* slot) {
    if (threadIdx.x == 0) *slot = (int)atomicAdd(ctr, 1u);
    __syncthreads();
    const int it = *slot;
    __syncthreads();
    return it;
}
__device__ __forceinline__ void phase_rec(const Params& p, LAS unsigned char* lds, int cbase) {
    unsigned* ctr = (unsigned*)(p.ws + WS_CTL) + cbase;
    LAS int* slot = (LAS int*)(lds + LDS_BYTES - 16);
    if (RECMASK & 1) for (;;) { const int it = queue_next(ctr + 0, slot); if (it >= N_ML_CHAIN) break; chain_item<true>(p, lds, it / 5, it % 5); }
    if (RECMASK & 2) for (;;) { const int it = queue_next(ctr + 1, slot); if (it >= N_HG_CHAIN) break; chain_item<false>(p, lds, it >> 1, it & 1); }
    if (RECMASK & 4) for (;;) { const int it = queue_next(ctr + 2, slot); if (it >= N_ML_STREAM) break; stream_item<true>(p, lds, it); }
    if (RECMASK & 8) for (;;) { const int it = queue_next(ctr + 3, slot); if (it >= N_HG_STREAM) break; stream_item<false>(p, lds, it); }
}

__device__ __forceinline__ void phase_branch(const Params& p) {
    const int lane = threadIdx.x & 63, gw = blockIdx.x * 8 + (threadIdx.x >> 6), NGW = gridDim.x * 8;
    const bf16_t* proj = (const bf16_t*)(p.ws + WS_PROJ);
    const float* HA = (const float*)(p.ws + WS_HA); const float* OB = (const float*)(p.ws + WS_OB);
    const float* DEN = (const float*)(p.ws + WS_DEN); const float* MT = (const float*)(p.ws + WS_MT);
    bf16_t* BRA = (bf16_t*)(p.ws + WS_BRA); bf16_t* BRB = (bf16_t*)(p.ws + WS_BRB);
    for (int row = gw; row < NT; row += NGW) {
#pragma unroll
        for (int h = 0; h < 4; ++h) {
            const float* hp = HA + (size_t)row * D + h * 512 + lane * 8;
            f32x4 v0 = *(const f32x4*)hp, v1 = *(const f32x4*)(hp + 4);
            const float den = DEN[(size_t)row * 4 + h], mtt = MT[(size_t)row * 4 + h];
            const float inv = 1.f / fmaxf(fabsf(den), expf(-mtt));
            v0 *= inv; v1 *= inv;
            const float mu = wave_sum((v0[0] + v0[1]) + (v0[2] + v0[3]) + (v1[0] + v1[1]) + (v1[2] + v1[3])) * (1.f / 512.f);
            v0 -= mu; v1 -= mu;
            const float var = wave_sum((v0[0] * v0[0] + v0[1] * v0[1]) + (v0[2] * v0[2] + v0[3] * v0[3]) + (v1[0] * v1[0] + v1[1] * v1[1]) + (v1[2] * v1[2] + v1[3] * v1[3])) * (1.f / 512.f);
            const float rstd = 1.f / sqrtf(var + LN_EPS);
            const f32x4 g0 = *(const f32x4*)(p.mlg + h * 512 + lane * 8), g1 = *(const f32x4*)(p.mlg + h * 512 + lane * 8 + 4);
            const u32x4 ov = *(const u32x4*)(proj + (size_t)row * NP + C_MLO + h * 512 + lane * 8);
            const float og[8] = {bflo(ov.x), bfhi(ov.x), bflo(ov.y), bfhi(ov.y), bflo(ov.z), bfhi(ov.z), bflo(ov.w), bfhi(ov.w)};
            float r[8];
#pragma unroll
            for (int e = 0; e < 4; ++e) { r[e] = v0[e] * rstd * g0[e] * sigmoidf_(og[e]); r[4 + e] = v1[e] * rstd * g1[e] * sigmoidf_(og[4 + e]); }
            u32x4 o; o.x = pk2(r[0], r[1]); o.y = pk2(r[2], r[3]); o.z = pk2(r[4], r[5]); o.w = pk2(r[6], r[7]);
            *(u32x4*)(BRA + (size_t)row * D + h * 512 + lane * 8) = o;
        }
#pragma unroll
        for (int h = 0; h < 8; ++h) {
            const f32x4 v = *(const f32x4*)(OB + (size_t)row * D + h * 256 + lane * 4);
            const float ms = wave_sum((v[0] * v[0] + v[1] * v[1]) + (v[2] * v[2] + v[3] * v[3])) * (1.f / 256.f);
            const float rstd = 1.f / sqrtf(ms + LN_EPS);
            const f32x4 g = *(const f32x4*)(p.hgg + h * 256 + lane * 4);
            const u32x2 gv = *(const u32x2*)(proj + (size_t)row * NP + C_HGG + h * 256 + lane * 4);
            const float gg[4] = {bflo(gv.x), bfhi(gv.x), bflo(gv.y), bfhi(gv.y)};
            float r[4];
#pragma unroll
            for (int e = 0; e < 4; ++e) r[e] = v[e] * rstd * g[e] * gg[e] * sigmoidf_(gg[e]);
            u32x2 o; o.x = pk2(r[0], r[1]); o.y = pk2(r[2], r[3]);
            *(u32x2*)(BRB + (size_t)row * D + h * 256 + lane * 4) = o;
        }
    }
}

template <bool WRITE_BF>
__device__ __forceinline__ void phase_ln(const float* Z, const float* RT, const float* PT, const float* gam, const float* bet, float* OF, bf16_t* OBF) {
    const int lane = threadIdx.x & 63, gw = blockIdx.x * 8 + (threadIdx.x >> 6), NGW = gridDim.x * 8;
    for (int row = gw; row < NT; row += NGW) {
        f32x4 v[8]; float s = 0.f;
        if (row < NTP) { const f32x4* zr = (const f32x4*)(Z + (size_t)row * D);
#pragma unroll
            for (int j = 0; j < 8; ++j) v[j] = zr[lane + 64 * j]; }
        else { const f32x4* rr = (const f32x4*)(RT + (size_t)(row - NTP) * D);
#pragma unroll
            for (int j = 0; j < 8; ++j) v[j] = rr[lane + 64 * j] * ALPHA;
#pragma unroll
            for (int sidx = 0; sidx < 8; ++sidx) { const f32x4* pr = (const f32x4*)(PT + ((size_t)sidx * NTS + (row - NTP)) * D);
#pragma unroll
                for (int j = 0; j < 8; ++j) v[j] += pr[lane + 64 * j]; } }
#pragma unroll
        for (int j = 0; j < 8; ++j) s += (v[j][0] + v[j][1]) + (v[j][2] + v[j][3]);
        const float mu = wave_sum(s) * (1.f / D); float s2 = 0.f;
#pragma unroll
        for (int j = 0; j < 8; ++j) { v[j] -= mu; s2 += (v[j][0] * v[j][0] + v[j][1] * v[j][1]) + (v[j][2] * v[j][2] + v[j][3] * v[j][3]); }
        const float rstd = 1.f / sqrtf(wave_sum(s2) * (1.f / D) + LN_EPS);
#pragma unroll
        for (int j = 0; j < 8; ++j) { const f32x4 g = ((const f32x4*)gam)[lane + 64 * j], bb = ((const f32x4*)bet)[lane + 64 * j];
            const f32x4 o = v[j] * rstd * g + bb;
            ((f32x4*)(OF + (size_t)row * D))[lane + 64 * j] = o;
            if (WRITE_BF) { u32x2 ob; ob.x = pk2(o[0], o[1]); ob.y = pk2(o[2], o[3]); ((u32x2*)(OBF + (size_t)row * D))[lane + 64 * j] = ob; } }
    }
}

constexpr int N_PHASES = 10;
#ifndef PHMASK
#define PHMASK 1023
#endif
#ifndef PROBE_DUP
#define PROBE_DUP -1
#endif
#define PH_BEGIN(k) if ((k) > p.ph_lo && (k) < p.ph_hi) xcd_barrier(xb); if ((PHMASK & (1 << (k))) && (k) >= p.ph_lo && (k) < p.ph_hi)
__global__ void __launch_bounds__(512, 2) mega(Params p) {
    extern __shared__ __attribute__((aligned(16))) unsigned char shm[];
    LAS unsigned char* lds = (LAS unsigned char*)shm;
    cg::grid_group grid = cg::this_grid();
    if (p.ph_lo < 0) grid.sync();
    volatile LAS unsigned* xst = (volatile LAS unsigned*)(lds + LDS_BYTES - 32);
    if (threadIdx.x == 0) { xst[0] = 0u; xst[1] = 0u; }
    __syncthreads();
    const XcdBarrier xb = xcd_barrier_post((unsigned*)(p.ws + WS_BAR), xst);
    PH_BEGIN(0) phase_prep(p, lds);
    PH_BEGIN(1) { pg8::StaticOrder S; S.init(NT, NP, D, gridDim.x, blockIdx.x); pg8::Gemm g{(const bf16_t*)(p.ws + WS_XB), (const bf16_t*)(p.ws + WS_WIN), NT, NP, D};
        pg8::EpiProj E{(bf16_t*)(p.ws + WS_PROJ), NP}; pg8::gemm_phase(lds, g, S, E); }
    PH_BEGIN(2) phase_rec(p, lds, 0);
    PH_BEGIN(3) phase_branch(p);
    PH_BEGIN(4) {
        pg8::TailOrder S; S.init(D, gridDim.x, blockIdx.x);
        { pg8::Gemm g{(const bf16_t*)(p.ws + WS_BRA), (const bf16_t*)(p.ws + WS_WA), NT, D, D};
            pg8::EpiMerge<0> E{(const bf16_t*)(p.ws + WS_PROJ), (float*)(p.ws + WS_TMP), (bf16_t*)(p.ws + WS_MRG), (float*)(p.ws + WS_PART)}; pg8::gemm_phase(lds, g, S, E); }
        __syncthreads();
        { pg8::Gemm g{(const bf16_t*)(p.ws + WS_BRB), (const bf16_t*)(p.ws + WS_WB), NT, D, D};
            pg8::EpiMerge<1> E{(const bf16_t*)(p.ws + WS_PROJ), (float*)(p.ws + WS_TMP), (bf16_t*)(p.ws + WS_MRG), (float*)(p.ws + WS_PART)}; pg8::gemm_phase(lds, g, S, E); }
        xcd_barrier(xb);
        { const f32x4* tz = (const f32x4*)(p.ws + WS_PART); u32x2* mo = (u32x2*)((bf16_t*)(p.ws + WS_MRG) + (size_t)NTP * D);
            for (int i = blockIdx.x * 512 + threadIdx.x; i < NTS * D / 4; i += gridDim.x * 512) { f32x4 v = tz[i];
#pragma unroll
                for (int sidx = 1; sidx < 16; ++sidx) v += tz[(size_t)sidx * (NTS * D / 4) + i];
                u32x2 o; o.x = pk2(v[0], v[1]); o.y = pk2(v[2], v[3]); mo[i] = o; } }
    }
    PH_BEGIN(5) { pg8::TailOrder S; S.init(D, gridDim.x, blockIdx.x); pg8::Gemm g{(const bf16_t*)(p.ws + WS_MRG), (const bf16_t*)(p.ws + WS_WOUT), NT, D, D};
        pg8::EpiRes E{p.xp, p.xs, NTP, (float*)(p.ws + WS_Z1), (float*)(p.ws + WS_PART)}; pg8::gemm_phase(lds, g, S, E); }
    PH_BEGIN(6) phase_ln<true>((const float*)(p.ws + WS_Z1), p.xs, (const float*)(p.ws + WS_PART), p.ln1g, p.ln1b, (float*)(p.ws + WS_X1F), (bf16_t*)(p.ws + WS_X1B));
    PH_BEGIN(7) { pg8::StaticOrder S; S.init(NT, DFF, D, gridDim.x, blockIdx.x); pg8::Gemm g{(const bf16_t*)(p.ws + WS_X1B), (const bf16_t*)(p.ws + WS_WUP), NT, DFF, D};
        pg8::EpiHid E{(bf16_t*)(p.ws + WS_HID), DFF}; pg8::gemm_phase(lds, g, S, E); }
    PH_BEGIN(8) { pg8::TailOrder S; S.init(DFF, gridDim.x, blockIdx.x); pg8::Gemm g{(const bf16_t*)(p.ws + WS_HID), (const bf16_t*)(p.ws + WS_WDN), NT, D, DFF};
        pg8::EpiRes E{(const float*)(p.ws + WS_X1F), (const float*)(p.ws + WS_X1F), NT, (float*)(p.ws + WS_Z2), (float*)(p.ws + WS_PART)}; pg8::gemm_phase(lds, g, S, E); }
    PH_BEGIN(9) phase_ln<false>((const float*)(p.ws + WS_Z2), (const float*)(p.ws + WS_X1F) + (size_t)NTP * D, (const float*)(p.ws + WS_PART), p.ln2g, p.ln2b, p.out + O_Y, nullptr);
}

#ifndef MK_MULTI
#define MK_MULTI 0
#endif
extern "C" void kernel_launch(void* const* d_in, const int* in_sizes, int n_in, void* d_out, int out_size, void* d_ws, size_t ws_size, hipStream_t stream) {
    static int grid = 0;
    if (grid == 0) {
        int dev = 0, cus = 0, per = 0;
        if (n_in != 21 || ws_size < WS_END) { fprintf(stderr, "kernel_launch: unexpected n_in %d / ws_size %zu (need %zu)\n", n_in, ws_size, (size_t)WS_END); grid = -1; return; }
        (void)hipGetDevice(&dev);
        (void)hipDeviceGetAttribute(&cus, hipDeviceAttributeMultiprocessorCount, dev);
        (void)hipFuncSetAttribute((const void*)mega, hipFuncAttributeMaxDynamicSharedMemorySize, LDS_BYTES);
        (void)hipOccupancyMaxActiveBlocksPerMultiprocessor(&per, (const void*)mega, 512, LDS_BYTES);
        if (per < 1) { fprintf(stderr, "kernel_launch: occupancy query says %d blocks per CU\n", per); per = 1; }
        grid = cus;
    }
    if (grid < 0) return;
    (void)hipMemsetAsync((char*)d_ws + WS_CTL, 0, 32768, stream);
    Params p{};
    const float** pp = (const float**)&p;
    for (int i = 0; i < 21; ++i) pp[i] = (const float*)d_in[i];
    p.out = (float*)d_out; p.ws = (unsigned char*)d_ws; p.rep = 2;
#if MK_MULTI
    for (int ph = 0; ph < N_PHASES; ++ph) { p.ph_lo = ph; p.ph_hi = ph + 1; hipLaunchKernelGGL(mega, dim3(grid), dim3(512), LDS_BYTES, stream, p); }
#else
    p.ph_lo = 0; p.ph_hi = N_PHASES;
    void* args[] = {&p};
    hipError_t e = hipLaunchCooperativeKernel((const void*)mega, dim3(grid), dim3(512), args, LDS_BYTES, stream);
    if (e != hipSuccess) fprintf(stderr, "kernel_launch: cooperative launch failed: %s (grid %d)\n", hipGetErrorString(e), grid);
#endif
}
```

```cpp
#include <hip/hip_runtime.h>
#include <hip/hip_cooperative_groups.h>
#include <cstdio>
#include <cstdint>
namespace cg = cooperative_groups;

#define LAS __attribute__((address_space(3)))
typedef unsigned short bf16_t;
typedef short bf16x8 __attribute__((ext_vector_type(8)));
typedef short bf16x4 __attribute__((ext_vector_type(4)));
typedef float f32x4 __attribute__((ext_vector_type(4)));
typedef float f32x2 __attribute__((ext_vector_type(2)));
typedef unsigned u32x4 __attribute__((ext_vector_type(4)));
typedef unsigned u32x2 __attribute__((ext_vector_type(2)));

constexpr int D = 2048, NTP = 8192, NTS = 1024, NT = 9216, DIN = 16392, NP = 16384, DFF = 8192;
constexpr int C_MLQ = 0, C_MLK = 1024, C_MLV = 2048, C_MLO = 4096, C_HGQ = 6144, C_HGF = 7168, C_HGI = 8192, C_HGG = 10240, C_GA = 12288, C_GB = 14336;
constexpr float LN_EPS = 1e-5f;
constexpr float ALPHA = 1.189207115002721f;
constexpr size_t O_Y = 0, O_CP = 18874368, O_NP = 20971520, O_MP = 20975616, O_SP = 20975632, O_CS = 22024208, O_NS = 89133072, O_MS = 89264144, O_SS = 89264656;
constexpr size_t WS_CTL = 0;
constexpr size_t WS_BAR = 4096;
constexpr size_t WS_WIN = 32768;
constexpr size_t WS_WA = WS_WIN + (size_t)NP * D * 2;
constexpr size_t WS_WB = WS_WA + (size_t)D * D * 2;
constexpr size_t WS_WOUT = WS_WB + (size_t)D * D * 2;
constexpr size_t WS_WUP = WS_WOUT + (size_t)D * D * 2;
constexpr size_t WS_WDN = WS_WUP + (size_t)DFF * D * 2;
constexpr size_t WS_XB = WS_WDN + (size_t)DFF * D * 2;
constexpr size_t WS_GATES = WS_XB + (size_t)NT * D * 2;
constexpr size_t WS_DEN = WS_GATES + (size_t)NT * 8 * 4;
constexpr size_t WS_MT = WS_DEN + (size_t)NT * 4 * 4;
constexpr size_t WS_PROJ = WS_MT + (size_t)NT * 4 * 4;
constexpr size_t WS_HA = WS_PROJ + (size_t)NT * NP * 2;
constexpr size_t WS_OB = WS_HA + (size_t)NT * D * 4;
constexpr size_t WS_BRA = WS_OB + (size_t)NT * D * 4;
constexpr size_t WS_BRB = WS_BRA + (size_t)NT * D * 2;
constexpr size_t WS_MRG = WS_BRB + (size_t)NT * D * 2;
constexpr size_t WS_PART = WS_MRG + (size_t)NT * D * 2;
constexpr size_t WS_END = WS_PART + (size_t)16 * NTS * D * 4;
constexpr size_t WS_TMP = WS_HA;
constexpr size_t WS_Z1 = WS_OB;
constexpr size_t WS_X1F = WS_PROJ;
constexpr size_t WS_X1B = WS_X1F + (size_t)NT * D * 4;
constexpr size_t WS_HID = WS_X1B + (size_t)NT * D * 2;
constexpr size_t WS_Z2 = WS_HA;
static_assert(WS_HID + (size_t)NT * DFF * 2 <= WS_HA, "overlay overflow");

constexpr int LDS_BYTES = 163840;

struct Params {
    const float *xp, *xs, *C0, *n0, *m0, *S0, *lbl, *w_in, *b_ig, *b_fg, *mlg, *hgg, *w_a, *w_b, *w_out, *ln1g, *ln1b, *w_up, *w_dn, *ln2g, *ln2b;
    float* out; unsigned char* ws;
    int ph_lo, ph_hi, rep, pad_;
};

__device__ __forceinline__ unsigned pk2(float lo, float hi) { unsigned r; asm("v_cvt_pk_bf16_f32 %0, %1, %2" : "=v"(r) : "v"(lo), "v"(hi)); return r; }
__device__ __forceinline__ float bflo(unsigned u) { return __uint_as_float(u << 16); }
__device__ __forceinline__ float bfhi(unsigned u) { return __uint_as_float(u & 0xffff0000u); }
__device__ __forceinline__ float bf1(unsigned short b) { return __uint_as_float(((unsigned)b) << 16); }
__device__ __forceinline__ float sigmoidf_(float x) { return __builtin_amdgcn_rcpf(1.f + __expf(-x)); }
__device__ __forceinline__ float wave_sum(float v) {
#pragma unroll
    for (int o = 1; o < 64; o <<= 1) v += __shfl_xor(v, o);
    return v;
}
#define LDS_WAIT() asm volatile("s_waitcnt lgkmcnt(0)" ::: "memory")
#define LDS_BAR() do { asm volatile("s_waitcnt lgkmcnt(0)" ::: "memory"); __builtin_amdgcn_s_barrier(); asm volatile("" ::: "memory"); } while (0)


#define XB_TMO      128
#define XB_XCNT(j)  (256  + 64 * (j))
#define XB_XSUB(j)  (1280 + 64 * (j))
#define XB_XGEN(j)  (2304 + 64 * (j))
#define XB_TOP      3328
#define XB_TOPGEN   3392
#define XCD_BAR_WORDS 3456
#define XB_SPIN_CAP (1u << 22)
__device__ __forceinline__ unsigned xb_ld(unsigned* p)              { return __hip_atomic_load(p, __ATOMIC_RELAXED, __HIP_MEMORY_SCOPE_AGENT); }
__device__ __forceinline__ unsigned xb_add(unsigned* p, unsigned v) { return __hip_atomic_fetch_add(p, v, __ATOMIC_RELAXED, __HIP_MEMORY_SCOPE_AGENT); }
__device__ __forceinline__ unsigned xb_xcc_id() { return (unsigned)__builtin_amdgcn_s_getreg((3 << 11) | 20) & 0xFu; }
#define XB_SPIN(cond, bar) do { unsigned _sp = 0; while (cond) { __builtin_amdgcn_s_sleep(1); \
    if ((++_sp & 255u) == 0u) { if (xb_ld(&(bar)[XB_TMO])) break; if (_sp > XB_SPIN_CAP) { atomicAdd(&(bar)[XB_TMO], 1u); break; } } } } while (0)
struct XcdBarrier { unsigned* bar; unsigned x; volatile LAS unsigned* st; };
__device__ __forceinline__ XcdBarrier xcd_barrier_post(unsigned* bar, volatile LAS unsigned* st) {
    XcdBarrier b; b.bar = bar; b.x = xb_xcc_id(); b.st = st;
    if (threadIdx.x == 0) (void)xb_add(&bar[XB_XCNT(b.x)], 1u);
    return b;
}
__device__ __forceinline__ void xcd_barrier_complete(unsigned* bar, unsigned x, unsigned& nloc, unsigned& nx) {
    const unsigned G = gridDim.x * gridDim.y * gridDim.z;
    unsigned sum, cnt, mine, sp = 0u;
    for (;;) {
        sum = 0u; cnt = 0u; mine = 0u;
#pragma unroll
        for (unsigned j = 0; j < 16; ++j) { const unsigned c = xb_ld(&bar[XB_XCNT(j)]); sum += c; cnt += (c > 0u) ? 1u : 0u; mine = (j == x) ? c : mine; }
        if (sum == G) break;
        __builtin_amdgcn_s_sleep(1);
        if ((++sp & 255u) == 0u) { if (xb_ld(&bar[XB_TMO])) break; if (sp > XB_SPIN_CAP) { atomicAdd(&bar[XB_TMO], 1u); break; } }
    }
    nloc = mine > 0u ? mine : 1u; nx = cnt > 0u ? cnt : 1u;
}
__device__ __forceinline__ void xcd_barrier(const XcdBarrier& b) {
    asm volatile("s_waitcnt vmcnt(0)" ::: "memory");
    __syncthreads();
    if (threadIdx.x == 0) {
        unsigned* bar = b.bar;
        __builtin_amdgcn_s_waitcnt(0);
        unsigned nloc = b.st[0], nx = b.st[1];
        if (nloc == 0u) { xcd_barrier_complete(bar, b.x, nloc, nx); b.st[0] = nloc; b.st[1] = nx; }
        const unsigned old = xb_add(&bar[XB_XSUB(b.x)], 1u);
        const unsigned gen = old / nloc;
        if (old + 1u == (gen + 1u) * nloc) {
            __builtin_amdgcn_fence(__ATOMIC_RELEASE, "agent");
            asm volatile("s_waitcnt vmcnt(0)" ::: "memory");
            const unsigned og = xb_add(&bar[XB_TOP], 1u);
            const unsigned tg = og / nx;
            if (og + 1u == (tg + 1u) * nx) xb_add(&bar[XB_TOPGEN], 1u);
            else XB_SPIN(xb_ld(&bar[XB_TOPGEN]) == tg, bar);
            __builtin_amdgcn_fence(__ATOMIC_ACQUIRE, "agent");
            xb_add(&bar[XB_XGEN(b.x)], 1u);
            asm volatile("s_waitcnt vmcnt(0)" ::: "memory");
        } else {
            XB_SPIN(xb_ld(&bar[XB_XGEN(b.x)]) == gen, bar);
            __builtin_amdgcn_fence(__ATOMIC_ACQUIRE, "agent");
            asm volatile("s_waitcnt vmcnt(0)" ::: "memory");
        }
    }
    __syncthreads();
}

namespace pg8 {
#define PG8_LAS __attribute__((address_space(3)))
constexpr int BM = 256, BK = 64, HALF = 128, HTB = HALF * BK * 2, STAGE_BYTES = 8 * HTB, NXCD = 8, WGM = 8;
__host__ __device__ __forceinline__ int lds_byte(int r, int c) { const int st = (r >> 4) * 2 + (c >> 5), rr = r & 15, cc = c & 31, ob = rr * 64 + cc * 2; return st * 1024 + (ob ^ (((ob >> 9) & 1) << 5)); }
__host__ __device__ __forceinline__ void stage_rc(int b, int& R, int& C) { const int st = b / 1024, sb = b % 1024, swz = sb ^ (((sb >> 9) & 1) << 5); R = (st >> 1) * 16 + swz / 64; C = (st & 1) * 32 + (swz % 64) / 2; }
__host__ __device__ __forceinline__ int perm32(int rho) { const int n = rho >> 4, i = rho & 15; return 8 * (i >> 2) + 4 * n + (i & 3); }
struct Unit { int pm, pn, k0, nt, mode; };
struct Gemm { const bf16_t* A; const bf16_t* Bt; int M, N, K; };
struct StaticOrder {
    int nM, nN, nwg, G, c, ntk;
    __host__ __device__ void init(int M, int N, int K, int G_, int c_) { nM = M / BM; nN = N / BM; nwg = nM * nN; G = G_; c = c_; ntk = K / BK; }
    __host__ __device__ void map(int wgid, Unit& u) const {
        { const int q = nwg / NXCD, r = nwg % NXCD, xcd = wgid % NXCD, off = wgid / NXCD; wgid = (xcd < r ? xcd * (q + 1) : r * (q + 1) + (xcd - r) * q) + off; }
        const int nig = WGM * nN, gid = wgid / nig, fm = gid * WGM, gsz = (nM - fm) < WGM ? (nM - fm) : WGM;
        u.pm = fm + ((wgid % nig) % gsz); u.pn = (wgid % nig) / gsz; u.k0 = 0; u.nt = ntk; u.mode = 0;
    }
    __host__ __device__ bool next(int i, Unit& u) const {
        const long L = (long)i * G + c; if (L >= nwg) return false;
        map((int)L, u); return true;
    }
    __device__ __forceinline__ void a_ready(const Unit&) const {}
    __device__ __forceinline__ void done(const Unit&) const {}
};
struct TailOrder : StaticOrder {
    int nsub, ksub;
    __host__ __device__ void init(int K, int G_, int c_) { StaticOrder::init(8192, 2048, K, G_, c_); nsub = 256; ksub = K / 8; }
    __host__ __device__ bool next(int i, Unit& u) const {
        const long L = (long)i * G + c;
        if (L < nwg) { map((int)L, u); return true; }
        const int j = (int)(L - nwg); if (j >= nsub) return false;
        const int uu = j >> 3, ks = j & 7;
        u.pm = 32 + (uu & 3); u.pn = uu >> 2; u.k0 = ks * ksub; u.nt = ksub / BK; u.mode = 1 + ks; return true;
    }
};
struct EpiProj {
    static constexpr bool PERM = true, AFTER_DRAIN = false;
    bf16_t* O; int ldc;
    __device__ __forceinline__ void operator()(const f32x4 (&acc)[2][2][4][2], const Unit& u, int wr, int wc, int fr, int fq) const {
        const int row0 = u.pm * BM + wr * 64 + fr, col0 = u.pn * BM + wc * 32 + 8 * fq;
#pragma unroll
        for (int ai = 0; ai < 2; ++ai)
#pragma unroll
            for (int m = 0; m < 4; ++m) { bf16_t* rowp = O + (size_t)(row0 + ai * HALF + m * 16) * ldc + col0;
#pragma unroll
                for (int bj = 0; bj < 2; ++bj) { const f32x4 v0 = acc[ai][bj][m][0], v1 = acc[ai][bj][m][1];
                    u32x4 o; o.x = pk2(v0[0], v0[1]); o.y = pk2(v0[2], v0[3]); o.z = pk2(v1[0], v1[1]); o.w = pk2(v1[2], v1[3]);
                    *(u32x4*)(rowp + bj * HALF) = o; } }
    }
};
struct EpiHid {
    static constexpr bool PERM = true, AFTER_DRAIN = false;
    bf16_t* O; int ldc;
    __device__ __forceinline__ void operator()(const f32x4 (&acc)[2][2][4][2], const Unit& u, int wr, int wc, int fr, int fq) const {
        const int row0 = u.pm * BM + wr * 64 + fr, col0 = u.pn * BM + wc * 32 + 8 * fq;
#pragma unroll
        for (int ai = 0; ai < 2; ++ai)
#pragma unroll
            for (int m = 0; m < 4; ++m) { bf16_t* rowp = O + (size_t)(row0 + ai * HALF + m * 16) * ldc + col0;
#pragma unroll
                for (int bj = 0; bj < 2; ++bj) { f32x4 v0 = acc[ai][bj][m][0], v1 = acc[ai][bj][m][1];
#pragma unroll
                    for (int e = 0; e < 4; ++e) { const float a = fmaxf(v0[e], 0.f), b = fmaxf(v1[e], 0.f); v0[e] = a * a; v1[e] = b * b; }
                    u32x4 o; o.x = pk2(v0[0], v0[1]); o.y = pk2(v0[2], v0[3]); o.z = pk2(v1[0], v1[1]); o.w = pk2(v1[2], v1[3]);
                    *(u32x4*)(rowp + bj * HALF) = o; } }
    }
};
template <int PASS> struct EpiMerge {
    static constexpr bool PERM = true, AFTER_DRAIN = false;
    const bf16_t* proj; float* tmp; bf16_t* O; bf16_t* tmpT;
    __device__ __forceinline__ void operator()(const f32x4 (&acc)[2][2][4][2], const Unit& u, int wr, int wc, int fr, int fq) const {
        const int row0 = u.pm * BM + wr * 64 + fr, col0 = u.pn * BM + wc * 32 + 8 * fq;
        const bool part = u.mode != 0;
#pragma unroll
        for (int ai = 0; ai < 2; ++ai)
#pragma unroll
            for (int m = 0; m < 4; ++m) { const size_t row = (size_t)(row0 + ai * HALF + m * 16);
#pragma unroll
                for (int bj = 0; bj < 2; ++bj) { const int col = col0 + bj * HALF;
                    const u32x4 gv = *(const u32x4*)(proj + row * NP + (PASS == 0 ? C_GA : C_GB) + col);
                    f32x4 s0, s1;
                    s0[0] = sigmoidf_(bflo(gv.x)); s0[1] = sigmoidf_(bfhi(gv.x)); s0[2] = sigmoidf_(bflo(gv.y)); s0[3] = sigmoidf_(bfhi(gv.y));
                    s1[0] = sigmoidf_(bflo(gv.z)); s1[1] = sigmoidf_(bfhi(gv.z)); s1[2] = sigmoidf_(bflo(gv.w)); s1[3] = sigmoidf_(bfhi(gv.w));
                    f32x4 v0 = acc[ai][bj][m][0] * s0, v1 = acc[ai][bj][m][1] * s1;
                    if (part) { bf16_t* tp = tmpT + ((size_t)(u.mode - 1) * NTS + (row - NTP)) * D + col;
                        if (PASS == 1) { const u32x4 pv = *(const u32x4*)tp; v0 += (f32x4){bflo(pv.x), bfhi(pv.x), bflo(pv.y), bfhi(pv.y)}; v1 += (f32x4){bflo(pv.z), bfhi(pv.z), bflo(pv.w), bfhi(pv.w)}; }
                        u32x4 o; o.x = pk2(v0[0], v0[1]); o.y = pk2(v0[2], v0[3]); o.z = pk2(v1[0], v1[1]); o.w = pk2(v1[2], v1[3]); *(u32x4*)tp = o; }
                    else { float* tp = tmp + row * D + col;
                        if (PASS == 0) { *(f32x4*)tp = v0; *(f32x4*)(tp + 4) = v1; }
                        else { v0 += *(const f32x4*)tp; v1 += *(const f32x4*)(tp + 4);
                            u32x4 o; o.x = pk2(v0[0], v0[1]); o.y = pk2(v0[2], v0[3]); o.z = pk2(v1[0], v1[1]); o.w = pk2(v1[2], v1[3]);
                            *(u32x4*)(O + row * D + col) = o; } }
                    __builtin_amdgcn_sched_barrier(0); } }
    }
};
template <bool RES_BF16> struct EpiRes {
    static constexpr bool PERM = false, AFTER_DRAIN = false;
    const float* rA; const float* rB; const bf16_t* rH; int split; bf16_t* Z; bf16_t* PT;
    __device__ __forceinline__ void operator()(const f32x4 (&acc)[2][2][4][2], const Unit& u, int wr, int wc, int fr, int fq) const {
        const int row0 = u.pm * BM + wr * 64 + fr, col0 = u.pn * BM + wc * 32 + 4 * fq;
        const bool part = u.mode != 0;
#pragma unroll
        for (int ai = 0; ai < 2; ++ai)
#pragma unroll
            for (int m = 0; m < 4; ++m) { const int row = row0 + ai * HALF + m * 16;
                const float* rp = (row < split ? rA + (size_t)row * D : rB + (size_t)(row - split) * D) + col0;
                const bf16_t* hp = rH + (size_t)row * D + col0;
                bf16_t* zp = Z + (size_t)row * D + col0;
#pragma unroll
                for (int bj = 0; bj < 2; ++bj)
#pragma unroll
                    for (int n = 0; n < 2; ++n) {
                        if (part) { const f32x4 a = acc[ai][bj][m][n]; u32x2 o; o.x = pk2(a[0], a[1]); o.y = pk2(a[2], a[3]); *(u32x2*)(PT + ((size_t)(u.mode - 1) * NTS + (row - NTP)) * D + col0 + bj * HALF + n * 16) = o; }
                        else { f32x4 r;
                            if (RES_BF16) { const u32x2 hv = *(const u32x2*)(hp + bj * HALF + n * 16); r = (f32x4){bflo(hv.x), bfhi(hv.x), bflo(hv.y), bfhi(hv.y)}; }
                            else r = *(const f32x4*)(rp + bj * HALF + n * 16);
                            const f32x4 z = r * ALPHA + acc[ai][bj][m][n];
                            u32x2 o; o.x = pk2(z[0], z[1]); o.y = pk2(z[2], z[3]);
                            *(u32x2*)(zp + bj * HALF + n * 16) = o; } } }
    }
};

template <class Epi, class Sched>
__device__ __forceinline__ void gemm_phase(PG8_LAS unsigned char* lds, const Gemm g, const Sched& S, const Epi& E) {
    const int tid = threadIdx.x, wid = __builtin_amdgcn_readfirstlane(tid >> 6), lane = tid & 63, wr = wid >> 2, wc = wid & 3, fr = lane & 15, fq = lane >> 4;
    const int K = g.K;
    unsigned voffA[2], voffB[2];
#pragma unroll
    for (int i = 0; i < 2; ++i) { int R, C; stage_rc(tid * 16 + i * 8192, R, C); const int Rb = Epi::PERM ? ((R & ~31) + perm32(R & 31)) : R;
        voffA[i] = (unsigned)(R * K + C) * 2u; voffB[i] = (unsigned)(Rb * K + C) * 2u; }
    const size_t kstep = (size_t)(BK * 2);
    const size_t hstep = (size_t)HALF * K * 2;
    const size_t tstep = 2 * hstep;
    const unsigned ldsw = (unsigned)wid * 1024u;
    const int aoff = lds_byte(wr * 64 + fr, fq * 8), boff = lds_byte(wc * 32 + fr, fq * 8);
#define PG8_SA(b, h) (((b) * 2 + (h)) * HTB)
#define PG8_SB(b, h) ((4 + (b) * 2 + (h)) * HTB)
#define PG8_STAGE(bufoff, gbase, voff) do { _Pragma("unroll") for (int _i = 0; _i < 2; ++_i) \
        __builtin_amdgcn_global_load_lds((const unsigned*)((const char*)(gbase) + (voff)[_i]), (PG8_LAS unsigned*)(lds + (bufoff) + ldsw + _i * 8192), 16, 0, 0); } while (0)
#define PG8_LDA(dst, b, h) do { _Pragma("unroll") for (int m = 0; m < 4; ++m) _Pragma("unroll") for (int k = 0; k < 2; ++k) dst[m][k] = *(const PG8_LAS bf16x8*)(lds + PG8_SA(b, h) + aoff + m * 2048 + k * 1024); } while (0)
#define PG8_LDB(dst, b, h) do { _Pragma("unroll") for (int n = 0; n < 2; ++n) _Pragma("unroll") for (int k = 0; k < 2; ++k) dst[n][k] = *(const PG8_LAS bf16x8*)(lds + PG8_SB(b, h) + boff + n * 2048 + k * 1024); } while (0)
#define PG8_MMA(ai, bj, At, Bt) do { __builtin_amdgcn_s_setprio(1); _Pragma("unroll") for (int m = 0; m < 4; ++m) _Pragma("unroll") for (int n = 0; n < 2; ++n) _Pragma("unroll") for (int k = 0; k < 2; ++k) \
        acc[ai][bj][m][n] = __builtin_amdgcn_mfma_f32_16x16x32_bf16(Bt[n][k], At[m][k], acc[ai][bj][m][n], 0, 0, 0); __builtin_amdgcn_s_setprio(0); } while (0)
#define PG8_WAIT_V(n) asm volatile("s_waitcnt vmcnt(" #n ")" ::: "memory")
#define PG8_WAIT_L(n) asm volatile("s_waitcnt lgkmcnt(" #n ")" ::: "memory")
#define PG8_BAR __builtin_amdgcn_s_barrier()
#define PG8_SCHED __builtin_amdgcn_sched_barrier(0)
    Unit cur, nxt; int ui = 0;
    if (!S.next(0, cur)) return;
    f32x4 acc[2][2][4][2];
#pragma unroll
    for (int a = 0; a < 2; ++a)
#pragma unroll
        for (int b = 0; b < 2; ++b)
#pragma unroll
            for (int m = 0; m < 4; ++m)
#pragma unroll
                for (int n = 0; n < 2; ++n) acc[a][b][m][n] = (f32x4){0.f, 0.f, 0.f, 0.f};
    bf16x8 At[4][2], B0[2][2], B1[2][2];
    const char* cA = (const char*)g.A + (size_t)cur.pm * tstep + (size_t)cur.k0 * 2; const char* cB = (const char*)g.Bt + (size_t)cur.pn * tstep + (size_t)cur.k0 * 2;
    S.a_ready(cur);
    PG8_STAGE(PG8_SB(0, 0), cB, voffB); PG8_STAGE(PG8_SA(0, 0), cA, voffA); PG8_STAGE(PG8_SB(0, 1), cB + hstep, voffB); PG8_STAGE(PG8_SA(0, 1), cA + hstep, voffA);
    if (wr == 1) PG8_BAR;
    PG8_WAIT_V(4); PG8_BAR;
    PG8_STAGE(PG8_SB(1, 0), cB + kstep, voffB); PG8_STAGE(PG8_SA(1, 0), cA + kstep, voffA); PG8_STAGE(PG8_SB(1, 1), cB + hstep + kstep, voffB);
    PG8_WAIT_V(6); PG8_BAR;
    for (;;) {
        const bool has_next = S.next(ui + 1, nxt);
        const char* nA = has_next ? (const char*)g.A + (size_t)nxt.pm * tstep + (size_t)nxt.k0 * 2 : cA; const char* nB = has_next ? (const char*)g.Bt + (size_t)nxt.pn * tstep + (size_t)nxt.k0 * 2 : cB;
        const int nt = cur.nt;
        for (int t = 0; t < nt; t += 2) {
            const bool last = (t == nt - 2);
            const char* a1 = cA + (size_t)(t + 1) * kstep;
            const char* a2 = last ? nA : cA + (size_t)(t + 2) * kstep; const char* b2 = last ? nB : cB + (size_t)(t + 2) * kstep;
            const char* a3 = a2 + kstep; const char* b3 = b2 + kstep;
            if (last && has_next) S.a_ready(nxt);
            PG8_LDB(B0, 0, 0); PG8_SCHED; PG8_LDA(At, 0, 0); PG8_STAGE(PG8_SA(1, 1), a1 + hstep, voffA);
            PG8_WAIT_L(8); PG8_BAR; PG8_WAIT_L(0); PG8_MMA(0, 0, At, B0); PG8_BAR; PG8_SCHED;
            PG8_LDB(B1, 0, 1); PG8_STAGE(PG8_SB(0, 0), b2, voffB);
            PG8_BAR; PG8_WAIT_L(0); PG8_MMA(0, 1, At, B1); PG8_BAR;
            PG8_LDA(At, 0, 1); PG8_STAGE(PG8_SA(0, 0), a2, voffA);
            PG8_BAR; PG8_WAIT_L(0); PG8_MMA(1, 0, At, B0); PG8_BAR; PG8_SCHED;
            PG8_STAGE(PG8_SB(0, 1), b2 + hstep, voffB);
            PG8_WAIT_V(6); PG8_BAR; PG8_MMA(1, 1, At, B1); PG8_BAR;
            PG8_LDB(B0, 1, 0); PG8_SCHED; PG8_LDA(At, 1, 0); PG8_STAGE(PG8_SA(0, 1), a2 + hstep, voffA);
            PG8_WAIT_L(8); PG8_BAR; PG8_WAIT_L(0); PG8_MMA(0, 0, At, B0); PG8_BAR; PG8_SCHED;
            PG8_LDB(B1, 1, 1); PG8_STAGE(PG8_SB(1, 0), b3, voffB);
            PG8_BAR; PG8_WAIT_L(0); PG8_MMA(0, 1, At, B1); PG8_BAR;
            PG8_LDA(At, 1, 1); PG8_STAGE(PG8_SA(1, 0), a3, voffA);
            PG8_BAR; PG8_WAIT_L(0); PG8_MMA(1, 0, At, B0); PG8_BAR; PG8_SCHED;
            PG8_STAGE(PG8_SB(1, 1), b3 + hstep, voffB);
            PG8_WAIT_V(6); PG8_BAR; PG8_MMA(1, 1, At, B1); PG8_BAR;
        }
        if constexpr (!Epi::AFTER_DRAIN) { E(acc, cur, wr, wc, fr, fq); S.done(cur); }
        if (!has_next) break;
#pragma unroll
        for (int a = 0; a < 2; ++a)
#pragma unroll
            for (int b = 0; b < 2; ++b)
#pragma unroll
                for (int m = 0; m < 4; ++m)
#pragma unroll
                    for (int n = 0; n < 2; ++n) acc[a][b][m][n] = (f32x4){0.f, 0.f, 0.f, 0.f};
        cur = nxt; cA = nA; cB = nB; ++ui;
    }
    PG8_WAIT_V(0);
    if (wr == 0) PG8_BAR;
    PG8_BAR;
    if constexpr (Epi::AFTER_DRAIN) { E.fused(acc, cur, wr, wc, fr, fq, lds, wid, lane); S.done(cur); }
#undef PG8_SA
#undef PG8_SB
#undef PG8_STAGE
#undef PG8_LDA
#undef PG8_LDB
#undef PG8_MMA
#undef PG8_WAIT_V
#undef PG8_WAIT_L
#undef PG8_BAR
#undef PG8_SCHED
}
}

__device__ __forceinline__ void transpose_item(const float* __restrict__ W, int src_ld, int src_col, bf16_t* __restrict__ WT, int K, int dst_row, int k0, LAS float* scr, int lane) {
    const int kr = lane >> 4, n4 = (lane & 15) * 4;
    f32x4 v[16];
#pragma unroll
    for (int i = 0; i < 16; ++i) v[i] = __builtin_nontemporal_load((const f32x4*)(W + (size_t)(k0 + i * 4 + kr) * src_ld + src_col + n4));
#pragma unroll
    for (int i = 0; i < 16; ++i) { LAS float* s = scr + (i * 4 + kr) * 65 + n4; s[0] = v[i][0]; s[1] = v[i][1]; s[2] = v[i][2]; s[3] = v[i][3]; }
    LDS_WAIT();
    const int c = lane & 7, nn = lane >> 3;
#pragma unroll
    for (int j = 0; j < 8; ++j) { const int n = nn + 8 * j; const LAS float* s = scr + (8 * c) * 65 + n;
        u32x4 o; o.x = pk2(s[0 * 65], s[1 * 65]); o.y = pk2(s[2 * 65], s[3 * 65]); o.z = pk2(s[4 * 65], s[5 * 65]); o.w = pk2(s[6 * 65], s[7 * 65]);
        *(u32x4*)(WT + (size_t)(dst_row + n) * K + k0 + 8 * c) = o; }
    LDS_WAIT();
}
__device__ __forceinline__ float log_sigmoid_(float x) { return fminf(x, 0.f) - log1pf(expf(-fabsf(x))); }

__device__ __forceinline__ void phase_prep(const Params& p, LAS unsigned char* lds) {
    const int tid = threadIdx.x, lane = tid & 63, wave = tid >> 6;
    LAS float* wg = (LAS float*)lds;
    LAS float* scr = (LAS float*)(lds + wave * 16640);
    bf16_t* WIN = (bf16_t*)(p.ws + WS_WIN); bf16_t* WA = (bf16_t*)(p.ws + WS_WA); bf16_t* WB = (bf16_t*)(p.ws + WS_WB);
    bf16_t* WOUT = (bf16_t*)(p.ws + WS_WOUT); bf16_t* WUP = (bf16_t*)(p.ws + WS_WUP); bf16_t* WDN = (bf16_t*)(p.ws + WS_WDN);
    const int gw = blockIdx.x * 8 + wave, NGW = gridDim.x * 8;
    constexpr int I_IN = 32 * 256, I_SQ = 32 * 32, I_UP = 32 * 128, I_DN = 128 * 32, NITEMS = I_IN + 3 * I_SQ + I_UP + I_DN;
    for (int it = gw; it < NITEMS; it += NGW) {
        int r = it;
        if (r < I_IN) { const int kb = r >> 8, nb = r & 255, n0 = nb * 64; transpose_item(p.w_in, DIN, n0 + (n0 >= 4096 ? 8 : 0), WIN, D, n0, kb * 64, scr, lane); continue; } r -= I_IN;
        if (r < I_SQ) { const int kb = r >> 5, nb = r & 31; transpose_item(p.w_a, D, nb * 64, WA, D, nb * 64, kb * 64, scr, lane); continue; } r -= I_SQ;
        if (r < I_SQ) { const int kb = r >> 5, nb = r & 31; transpose_item(p.w_b, D, nb * 64, WB, D, nb * 64, kb * 64, scr, lane); continue; } r -= I_SQ;
        if (r < I_SQ) { const int kb = r >> 5, nb = r & 31; transpose_item(p.w_out, D, nb * 64, WOUT, D, nb * 64, kb * 64, scr, lane); continue; } r -= I_SQ;
        if (r < I_UP) { const int kb = r >> 7, nb = r & 127; transpose_item(p.w_up, DFF, nb * 64, WUP, D, nb * 64, kb * 64, scr, lane); continue; } r -= I_UP;
        { const int kb = r >> 5, nb = r & 31; transpose_item(p.w_dn, D, nb * 64, WDN, DFF, nb * 64, kb * 64, scr, lane); }
    }
    __syncthreads();
    for (int d = tid; d < D; d += 512) {
        const f32x4 a = *(const f32x4*)(p.w_in + (size_t)d * DIN + 4096), b = *(const f32x4*)(p.w_in + (size_t)d * DIN + 4100);
#pragma unroll
        for (int q = 0; q < 4; ++q) { wg[q * 2048 + d] = a[q]; wg[(4 + q) * 2048 + d] = b[q]; }
    }
    __syncthreads();
    bf16_t* XB = (bf16_t*)(p.ws + WS_XB); float* GATES = (float*)(p.ws + WS_GATES);
    for (int row = gw; row < NT; row += NGW) {
        const float* xr = row < NTP ? p.xp + (size_t)row * D : p.xs + (size_t)(row - NTP) * D;
        float gs[8];
#pragma unroll
        for (int e = 0; e < 8; ++e) gs[e] = 0.f;
#pragma unroll
        for (int j = 0; j < 8; ++j) {
            const f32x4 v = ((const f32x4*)xr)[lane + 64 * j];
            u32x2 o; o.x = pk2(v[0], v[1]); o.y = pk2(v[2], v[3]);
            ((u32x2*)(XB + (size_t)row * D))[lane + 64 * j] = o;
#pragma unroll
            for (int q = 0; q < 8; ++q) { const f32x4 wv = *(const LAS f32x4*)(wg + q * 2048 + 4 * (lane + 64 * j));
                gs[q] += (v[0] * wv[0] + v[1] * wv[1]) + (v[2] * wv[2] + v[3] * wv[3]); }
        }
#pragma unroll
        for (int e = 0; e < 8; ++e) gs[e] = wave_sum(gs[e]);
        if (lane < 4) { float gi = lane == 0 ? gs[0] : lane == 1 ? gs[1] : lane == 2 ? gs[2] : gs[3];
            float gf = lane == 0 ? gs[4] : lane == 1 ? gs[5] : lane == 2 ? gs[6] : gs[7];
            GATES[(size_t)row * 8 + lane] = gi + p.b_ig[lane];
            GATES[(size_t)row * 8 + 4 + lane] = log_sigmoid_(gf + p.b_fg[lane]); }
    }
}

template <bool IS_ML>
__device__ __forceinline__ void chain_item(const Params& p, LAS unsigned char* lds, int bh, int sl) {
    constexpr int DK = IS_ML ? 256 : 128, NPC = DK / 64, NRB = DK / 16;
    constexpr int QS = (DK + 8) * 2, TS = 144, VRS = 272;
    constexpr int OFF_Q = 0, OFF_K = OFF_Q + 64 * QS, OFF_KT = OFF_K + 64 * QS, OFF_VT = OFF_KT + DK * TS, OFF_VR = OFF_VT + 128 * TS, OFF_P = OFF_VR + 64 * VRS, OFF_SM = OFF_P + 64 * TS;
    static_assert(OFF_SM + 10240 + 16 <= LDS_BYTES, "chain LDS");
    const int tid = threadIdx.x, lane = tid & 63, w = tid >> 6, g = lane >> 4, c16 = lane & 15;
    const int b = IS_ML ? (bh >> 2) : (bh >> 3), h = IS_ML ? (bh & 3) : (bh & 7);
    const bool isden = IS_ML && sl == 4;
    const int qcol = IS_ML ? C_MLQ + h * 256 : C_HGQ + h * 128, kcol = IS_ML ? C_MLK + h * 256 : C_HGF + h * 128;
    const int vcol = IS_ML ? C_MLV + h * 512 + (isden ? 0 : sl) * 128 : C_HGI + h * 256 + sl * 128;
    const bf16_t* proj = (const bf16_t*)(p.ws + WS_PROJ);
    const float* GATES = (const float*)(p.ws + WS_GATES);
    const size_t tok0 = (size_t)b * 2048;
    LAS unsigned char* Q = lds + OFF_Q; LAS unsigned char* Kr = lds + OFF_K; LAS unsigned char* KT = lds + OFF_KT;
    LAS unsigned char* VT = lds + OFF_VT; LAS unsigned char* VR = lds + OFF_VR; LAS unsigned char* P = lds + OFF_P;
    LAS float* SM = (LAS float*)(lds + OFF_SM);
    LAS float* SMW = SM + w * 320;
    const int prow = tid >> 3, pseg = tid & 7;
    u32x4 pq[NPC], pk[NPC], pv[2]; float pig = 0.f, plf = 0.f;
    auto prefetch = [&](int c) {
        const bf16_t* rp = proj + (tok0 + c * 64 + prow) * NP;
#pragma unroll
        for (int i = 0; i < NPC; ++i) { pq[i] = *(const u32x4*)(rp + qcol + i * 64 + pseg * 8); pk[i] = *(const u32x4*)(rp + kcol + i * 64 + pseg * 8); }
        if (!isden) {
#pragma unroll
            for (int i = 0; i < 2; ++i) pv[i] = *(const u32x4*)(rp + vcol + i * 64 + pseg * 8); }
        if (IS_ML) { pig = GATES[(tok0 + c * 64 + lane) * 8 + h]; plf = GATES[(tok0 + c * 64 + lane) * 8 + 4 + h]; }
    };
    prefetch(0);
    f32x4 S[NRB];
#pragma unroll
    for (int i = 0; i < NRB; ++i) S[i] = (f32x4){0.f, 0.f, 0.f, 0.f};
    float m_prev = 0.f;
    float lbk = 0.f;
    if (!IS_ML) { const int k = tid & 127; lbk = sigmoidf_(p.lbl[h * 128 + k] - p.lbl[1024 + h * 128 + k]); }
    float* OUT = (float*)(p.ws + (IS_ML ? WS_HA : WS_OB));
    const int ocol = IS_ML ? h * 512 + sl * 128 + w * 16 + c16 : h * 256 + sl * 128 + w * 16 + c16;

    for (int c = 0; c < 32; ++c) {
#pragma unroll
        for (int i = 0; i < NPC; ++i) { *(LAS u32x4*)(Q + prow * QS + (i * 64 + pseg * 8) * 2) = pq[i]; *(LAS u32x4*)(Kr + prow * QS + (i * 64 + pseg * 8) * 2) = pk[i]; }
        if (!isden) {
#pragma unroll
            for (int i = 0; i < 2; ++i) *(LAS u32x4*)(VR + prow * VRS + (i * 64 + pseg * 8) * 2) = pv[i]; }
        const float ig = pig, lf = plf;
        if (c + 1 < 32) prefetch(c + 1);
        LDS_BAR();
        float a_t = 0.f, M_t = 0.f, wint = 1.f, mt = 0.f, decay = 1.f, m_new = 0.f;
        if (IS_ML) {
            float bt = lf;
#pragma unroll
            for (int o = 1; o < 64; o <<= 1) { const float y = __shfl_up(bt, o); if (lane >= o) bt += y; }
            a_t = ig - bt;
            float cm = a_t;
#pragma unroll
            for (int o = 1; o < 64; o <<= 1) { const float y = __shfl_up(cm, o); if (lane >= o) cm = fmaxf(cm, y); }
            M_t = fmaxf(m_prev, cm);
            const float M_end = __shfl(M_t, 63), b_end = __shfl(bt, 63);
            wint = __expf(m_prev - M_t); mt = bt + M_t;
            const float wend = __expf(a_t - M_end);
            decay = __expf(m_prev - M_end); m_new = b_end + M_end;
            SMW[lane] = a_t; SMW[64 + lane] = M_t; SMW[128 + lane] = wint; SMW[192 + lane] = mt; SMW[256 + lane] = wend;
            LDS_WAIT();
            { const int sp = tid & 31, seg = tid >> 5;
                const f32x2 wv = *(const LAS f32x2*)(SMW + 256 + 2 * sp); const float w0 = wv[0] * 0.0625f, w1 = wv[1] * 0.0625f;
                const u32x4 r0a = *(const LAS u32x4*)(Kr + (2 * sp) * QS + seg * 32), r0b = *(const LAS u32x4*)(Kr + (2 * sp) * QS + seg * 32 + 16);
                const u32x4 r1a = *(const LAS u32x4*)(Kr + (2 * sp + 1) * QS + seg * 32), r1b = *(const LAS u32x4*)(Kr + (2 * sp + 1) * QS + seg * 32 + 16);
                const unsigned x0[8] = {r0a.x, r0a.y, r0a.z, r0a.w, r0b.x, r0b.y, r0b.z, r0b.w};
                const unsigned x1[8] = {r1a.x, r1a.y, r1a.z, r1a.w, r1b.x, r1b.y, r1b.z, r1b.w};
#pragma unroll
                for (int e = 0; e < 8; ++e) {
                    *(LAS unsigned*)(KT + (seg * 16 + 2 * e) * TS + sp * 4) = pk2(bflo(x0[e]) * w0, bflo(x1[e]) * w1);
                    *(LAS unsigned*)(KT + (seg * 16 + 2 * e + 1) * TS + sp * 4) = pk2(bfhi(x0[e]) * w0, bfhi(x1[e]) * w1); }
            }
        } else {
            const int k = tid & 127, tq = tid >> 7;
            float G[16], kc[16], qv[16];
            float run = 0.f;
#pragma unroll
            for (int i = 0; i < 16; ++i) { const int t = tq * 16 + i;
                const float x = bf1(*(const LAS unsigned short*)(Kr + t * QS + k * 2));
                qv[i] = bf1(*(const LAS unsigned short*)(Q + t * QS + k * 2));
                const float sp_ = __builtin_amdgcn_rcpf(1.f + __expf(-x)), sm_ = __builtin_amdgcn_rcpf(1.f + __expf(x));
                const float f = lbk + (1.f - lbk) * sp_;
                kc[i] = (1.f - lbk) * sm_;
                run += __logf(f); G[i] = run; }
            SM[tq * 128 + k] = run;
            LDS_BAR();
            const float t0 = SM[k], t1 = SM[128 + k], t2 = SM[256 + k], t3 = SM[384 + k];
            const float pre = (tq > 0 ? t0 : 0.f) + (tq > 1 ? t1 : 0.f) + (tq > 2 ? t2 : 0.f);
            const float Gend = (t0 + t1) + (t2 + t3);
            if (tq == 0) SM[512 + k] = __expf(Gend);
            unsigned kt[8];
#pragma unroll
            for (int i = 0; i < 16; i += 2) {
                const float d0 = Gend - (pre + G[i]), d1 = Gend - (pre + G[i + 1]);
                const float kg0 = kc[i] * __expf(d0), kg1 = kc[i + 1] * __expf(d1);
                const float qg0 = qv[i] * __expf(-d0), qg1 = qv[i + 1] * __expf(-d1);
                const unsigned kp = pk2(kg0, kg1), qp = pk2(qg0, qg1);
                kt[i >> 1] = kp;
                *(LAS unsigned short*)(Kr + (tq * 16 + i) * QS + k * 2) = (unsigned short)(kp & 0xffffu);
                *(LAS unsigned short*)(Kr + (tq * 16 + i + 1) * QS + k * 2) = (unsigned short)(kp >> 16);
                *(LAS unsigned short*)(Q + (tq * 16 + i) * QS + k * 2) = (unsigned short)(qp & 0xffffu);
                *(LAS unsigned short*)(Q + (tq * 16 + i + 1) * QS + k * 2) = (unsigned short)(qp >> 16); }
            *(LAS u32x4*)(KT + k * TS + tq * 32) = (u32x4){kt[0], kt[1], kt[2], kt[3]};
            *(LAS u32x4*)(KT + k * TS + tq * 32 + 16) = (u32x4){kt[4], kt[5], kt[6], kt[7]};
        }
        if (!isden && tid < 256) { const int sp = tid & 31, seg = tid >> 5;
            const u32x4 r0a = *(const LAS u32x4*)(VR + (2 * sp) * VRS + seg * 32), r0b = *(const LAS u32x4*)(VR + (2 * sp) * VRS + seg * 32 + 16);
            const u32x4 r1a = *(const LAS u32x4*)(VR + (2 * sp + 1) * VRS + seg * 32), r1b = *(const LAS u32x4*)(VR + (2 * sp + 1) * VRS + seg * 32 + 16);
            const unsigned x0[8] = {r0a.x, r0a.y, r0a.z, r0a.w, r0b.x, r0b.y, r0b.z, r0b.w};
            const unsigned x1[8] = {r1a.x, r1a.y, r1a.z, r1a.w, r1b.x, r1b.y, r1b.z, r1b.w};
#pragma unroll
            for (int e = 0; e < 8; ++e) {
                *(LAS unsigned*)(VT + (seg * 16 + 2 * e) * TS + sp * 4) = (x0[e] & 0xffffu) | (x1[e] << 16);
                *(LAS unsigned*)(VT + (seg * 16 + 2 * e + 1) * TS + sp * 4) = (x0[e] >> 16) | (x1[e] & 0xffff0000u); }
        }
        if (!IS_ML) LDS_BAR();
        { const int tr = w >> 1;
#pragma unroll
            for (int ti = 0; ti < 2; ++ti) { const int tc = (w & 1) * 2 + ti;
                f32x4 acc = (f32x4){0.f, 0.f, 0.f, 0.f};
                if (tc <= tr) {
#pragma unroll
                    for (int kk = 0; kk < DK / 32; ++kk) {
                        const bf16x8 A = *(const LAS bf16x8*)(Q + (tr * 16 + c16) * QS + (kk * 32 + g * 8) * 2);
                        const bf16x8 B = *(const LAS bf16x8*)(Kr + (tc * 16 + c16) * QS + (kk * 32 + g * 8) * 2);
                        acc = __builtin_amdgcn_mfma_f32_16x16x32_bf16(A, B, acc, 0, 0, 0); }
                }
                const int s = tc * 16 + c16;
                float as_ = 0.f; f32x4 Mv = (f32x4){0.f, 0.f, 0.f, 0.f};
                if (IS_ML) { as_ = SMW[s]; Mv = *(const LAS f32x4*)(SMW + 64 + tr * 16 + g * 4); }
#pragma unroll
                for (int j = 0; j < 4; ++j) { const int t = tr * 16 + g * 4 + j;
                    float v = acc[j];
                    if (IS_ML) { v = v * 0.0625f * __expf(fminf(as_ - Mv[j], 0.f)); }
                    v = (s <= t) ? v : 0.f;
                    *(LAS unsigned short*)(P + t * TS + s * 2) = (unsigned short)(pk2(v, 0.f) & 0xffffu); }
            }
        }
        LDS_BAR();
        if (!isden || w == 0) {
            bf16x8 Bv[2];
            if (isden) { const short one = (c16 == 0) ? (short)0x3F80 : (short)0;
                Bv[0] = (bf16x8){one, one, one, one, one, one, one, one}; Bv[1] = Bv[0]; }
            else {
#pragma unroll
                for (int ks = 0; ks < 2; ++ks) Bv[ks] = *(const LAS bf16x8*)(VT + (w * 16 + c16) * TS + (ks * 32 + g * 8) * 2); }
            if (!IS_ML) {
#pragma unroll
                for (int rb = 0; rb < NRB; ++rb) { const f32x4 dv = *(const LAS f32x4*)(SM + 512 + rb * 16 + g * 4); S[rb] = S[rb] * dv; } }
            f32x4 o2[4];
#pragma unroll
            for (int tt = 0; tt < 4; ++tt) o2[tt] = (f32x4){0.f, 0.f, 0.f, 0.f};
#pragma unroll
            for (int i = 0; i < NRB / 2; ++i) {
                const unsigned b0 = pk2(S[2 * i][0], S[2 * i][1]), b1 = pk2(S[2 * i][2], S[2 * i][3]), b2 = pk2(S[2 * i + 1][0], S[2 * i + 1][1]), b3 = pk2(S[2 * i + 1][2], S[2 * i + 1][3]);
                const u32x4 bu = (u32x4){b0, b1, b2, b3};
                const bf16x8 Bs = __builtin_bit_cast(bf16x8, bu);
#pragma unroll
                for (int tt = 0; tt < 4; ++tt) {
                    const u32x2 a0 = *(const LAS u32x2*)(Q + (tt * 16 + c16) * QS + ((2 * i) * 16 + g * 4) * 2);
                    const u32x2 a1 = *(const LAS u32x2*)(Q + (tt * 16 + c16) * QS + ((2 * i + 1) * 16 + g * 4) * 2);
                    const u32x4 au = (u32x4){a0.x, a0.y, a1.x, a1.y};
                    o2[tt] = __builtin_amdgcn_mfma_f32_16x16x32_bf16(__builtin_bit_cast(bf16x8, au), Bs, o2[tt], 0, 0, 0); }
                if ((i & 1) == 1) __builtin_amdgcn_sched_barrier(0);
            }
            if (IS_ML) {
#pragma unroll
                for (int tt = 0; tt < 4; ++tt) o2[tt] = o2[tt] * *(const LAS f32x4*)(SMW + 128 + tt * 16 + g * 4); }
#pragma unroll
            for (int tt = 0; tt < 4; ++tt) {
#pragma unroll
                for (int ks = 0; ks < 2; ++ks) { const bf16x8 A = *(const LAS bf16x8*)(P + (tt * 16 + c16) * TS + (ks * 32 + g * 8) * 2);
                    o2[tt] = __builtin_amdgcn_mfma_f32_16x16x32_bf16(A, Bv[ks], o2[tt], 0, 0, 0); } }
#pragma unroll
            for (int tt = 0; tt < 4; ++tt)
#pragma unroll
                for (int j = 0; j < 4; ++j) { const int t = tt * 16 + g * 4 + j;
                    const float v = o2[tt][j];
                    const size_t tok = tok0 + c * 64 + t;
                    if (isden) { const float mtt = SMW[192 + t];
                        if (c16 == 0) { ((float*)(p.ws + WS_DEN))[tok * 4 + h] = v; ((float*)(p.ws + WS_MT))[tok * 4 + h] = mtt; } }
                    else OUT[tok * D + ocol] = v; }
            __builtin_amdgcn_sched_barrier(0);
#pragma unroll
            for (int rb = 0; rb < NRB; ++rb) {
                f32x4 acc = IS_ML ? S[rb] * decay : S[rb];
#pragma unroll
                for (int ks = 0; ks < 2; ++ks) { const bf16x8 A = *(const LAS bf16x8*)(KT + (rb * 16 + c16) * TS + (ks * 32 + g * 8) * 2);
                    acc = __builtin_amdgcn_mfma_f32_16x16x32_bf16(A, Bv[ks], acc, 0, 0, 0); }
                S[rb] = acc;
                if ((rb & 3) == 3) __builtin_amdgcn_sched_barrier(0); }
        }
        m_prev = m_new;
        LDS_BAR();
    }
    if (IS_ML) {
        if (!isden) { float* Co = p.out + O_CP + (size_t)bh * 256 * 512 + sl * 128 + w * 16 + c16;
#pragma unroll
            for (int rb = 0; rb < NRB; ++rb)
#pragma unroll
                for (int j = 0; j < 4; ++j) Co[(size_t)(rb * 16 + g * 4 + j) * 512] = S[rb][j]; }
        else if (w == 0) {
            if (c16 == 0) {
#pragma unroll
                for (int rb = 0; rb < NRB; ++rb)
#pragma unroll
                    for (int j = 0; j < 4; ++j) p.out[O_NP + (size_t)bh * 256 + rb * 16 + g * 4 + j] = S[rb][j]; }
            if (lane == 0) p.out[O_MP + bh] = m_prev; }
    } else {
        float* So = p.out + O_SP + (size_t)bh * 128 * 256 + sl * 128 + w * 16 + c16;
#pragma unroll
        for (int rb = 0; rb < NRB; ++rb)
#pragma unroll
            for (int j = 0; j < 4; ++j) So[(size_t)(rb * 16 + g * 4 + j) * 256] = S[rb][j];
    }
}

template <bool IS_ML>
__device__ __forceinline__ void stream_item(const Params& p, LAS unsigned char* lds, int bh) {
    constexpr int K = IS_ML ? 256 : 128, V = IS_ML ? 512 : 256, NH = IS_ML ? 4 : 8;
    constexpr int CG = V / 4, RG = 512 / CG, NR = K / RG, U = 8;
    constexpr int OFF_A = 0, OFF_B = OFF_A + K * 64, OFF_DEC = OFF_B + K * 64, OFF_VV = OFF_DEC + K * 4, OFF_PP = OFF_VV + 8 * V * 4, OFF_PART = OFF_PP + 256, OFF_QN = OFF_PART + 2048, OFF_RED = OFF_QN + 256;
    static_assert(OFF_RED + RG * 8 * V * 4 <= LDS_BYTES, "stream LDS");
    LAS float* A16 = (LAS float*)(lds + OFF_A); LAS float* B16 = (LAS float*)(lds + OFF_B); LAS float* DEC = (LAS float*)(lds + OFF_DEC);
    LAS float* VV = (LAS float*)(lds + OFF_VV); LAS float* PP = (LAS float*)(lds + OFF_PP); LAS float* PART = (LAS float*)(lds + OFF_PART);
    LAS float* QN = (LAS float*)(lds + OFF_QN); LAS float* RED = (LAS float*)(lds + OFF_RED);
    const int tid = threadIdx.x, lane = tid & 63, w = tid >> 6;
    const int b = bh / NH, h = bh % NH;
    const size_t tok0 = (size_t)NTP + (size_t)b * 8;
    const bf16_t* proj = (const bf16_t*)(p.ws + WS_PROJ);
    float wint[8], a_[8], M_[8], mt[8]; float decay = 1.f, m_new = 0.f;
#pragma unroll
    for (int t = 0; t < 8; ++t) { wint[t] = 1.f; a_[t] = 0.f; M_[t] = 0.f; mt[t] = 0.f; }
    if (IS_ML) {
        const float* GATES = (const float*)(p.ws + WS_GATES);
        const float m0 = p.m0[bh];
        float bt = 0.f, cm = -3.0e38f, wend[8];
#pragma unroll
        for (int t = 0; t < 8; ++t) { const float ig = GATES[(tok0 + t) * 8 + h], lf = GATES[(tok0 + t) * 8 + 4 + h];
            bt += lf; a_[t] = ig - bt; cm = fmaxf(cm, a_[t]); M_[t] = fmaxf(m0, cm); mt[t] = bt + M_[t]; wint[t] = __expf(m0 - M_[t]); }
        const float M_end = M_[7];
        decay = __expf(m0 - M_end); m_new = bt + M_end;
#pragma unroll
        for (int t = 0; t < 8; ++t) wend[t] = __expf(a_[t] - M_end);
        { const int t = tid >> 6, k4 = (tid & 63) * 4;
            const u32x2 qv = *(const u32x2*)(proj + (tok0 + t) * NP + C_MLQ + h * 256 + k4), kv = *(const u32x2*)(proj + (tok0 + t) * NP + C_MLK + h * 256 + k4);
            const float qf[4] = {bflo(qv.x), bfhi(qv.x), bflo(qv.y), bfhi(qv.y)};
            const float kf[4] = {bflo(kv.x) * 0.0625f, bfhi(kv.x) * 0.0625f, bflo(kv.y) * 0.0625f, bfhi(kv.y) * 0.0625f};
            float we = wend[0];
#pragma unroll
            for (int u = 1; u < 8; ++u) we = (t == u) ? wend[u] : we;
#pragma unroll
            for (int e = 0; e < 4; ++e) { A16[(k4 + e) * 16 + t] = qf[e]; A16[(k4 + e) * 16 + 8 + t] = kf[e] * we; B16[(k4 + e) * 16 + t] = qf[e]; B16[(k4 + e) * 16 + 8 + t] = kf[e]; } }
        { const int t = tid >> 6, c8 = (tid & 63) * 8;
            const u32x4 vv = *(const u32x4*)(proj + (tok0 + t) * NP + C_MLV + h * 512 + c8);
            *(LAS f32x4*)(VV + t * V + c8) = (f32x4){bflo(vv.x), bfhi(vv.x), bflo(vv.y), bfhi(vv.y)};
            *(LAS f32x4*)(VV + t * V + c8 + 4) = (f32x4){bflo(vv.z), bfhi(vv.z), bflo(vv.w), bfhi(vv.w)}; }
    } else {
        if (tid < 128) { const int k = tid;
            const float lbk = sigmoidf_(p.lbl[h * 128 + k] - p.lbl[1024 + h * 128 + k]);
            float G[8], kc[8], qv[8]; float run = 0.f;
#pragma unroll
            for (int t = 0; t < 8; ++t) { const float x = bf1(proj[(tok0 + t) * NP + C_HGF + h * 128 + k]); qv[t] = bf1(proj[(tok0 + t) * NP + C_HGQ + h * 128 + k]);
                const float sp_ = __builtin_amdgcn_rcpf(1.f + __expf(-x)), sm_ = __builtin_amdgcn_rcpf(1.f + __expf(x));
                const float f = lbk + (1.f - lbk) * sp_; kc[t] = (1.f - lbk) * sm_; run += __logf(f); G[t] = run; }
            const float dec = __expf(run);
            DEC[k] = dec;
#pragma unroll
            for (int t = 0; t < 8; ++t) { const float e = __expf(run - G[t]), kw = kc[t] * e, qg = qv[t] * __expf(G[t] - run);
                A16[k * 16 + t] = qg * dec; A16[k * 16 + 8 + t] = kw; B16[k * 16 + t] = qg; B16[k * 16 + 8 + t] = kw; } }
        { const int t = tid >> 6, c4 = (tid & 63) * 4;
            const u32x2 vv = *(const u32x2*)(proj + (tok0 + t) * NP + C_HGI + h * 256 + c4);
            *(LAS f32x4*)(VV + t * V + c4) = (f32x4){bflo(vv.x), bfhi(vv.x), bflo(vv.y), bfhi(vv.y)}; }
    }
    __syncthreads();
    { const int pair = tid & 63, t = pair >> 3, s = pair & 7, part = tid >> 6; float acc = 0.f;
#pragma unroll 8
        for (int k = part * (K / 8); k < (part + 1) * (K / 8); ++k) acc += B16[k * 16 + t] * B16[k * 16 + 8 + s];
        PART[part * 64 + pair] = acc; }
    if (IS_ML && tid < 256) { const int dk = tid; const float n0v = p.n0[(size_t)bh * 256 + dk];
        float nn = decay * n0v;
#pragma unroll
        for (int s = 0; s < 8; ++s) nn += A16[dk * 16 + 8 + s];
        p.out[O_NS + (size_t)bh * 256 + dk] = nn;
#pragma unroll
        for (int t = 0; t < 8; ++t) { const float pr = wave_sum(A16[dk * 16 + t] * n0v); if (lane == 0) QN[w * 8 + t] = pr; } }
    __syncthreads();
    if (tid < 64) { const int t = tid >> 3, s = tid & 7; float v = 0.f;
#pragma unroll
        for (int q = 0; q < 8; ++q) v += PART[q * 64 + tid];
        if (IS_ML) { float as_ = a_[0], Mt = M_[0];
#pragma unroll
            for (int u = 1; u < 8; ++u) { as_ = (s == u) ? a_[u] : as_; Mt = (t == u) ? M_[u] : Mt; }
            v *= __expf(fminf(as_ - Mt, 0.f)); }
        PP[tid] = (s <= t) ? v : 0.f; }
    __syncthreads();
    if (IS_ML && tid < 8) { const int t = tid; float den = 0.f;
#pragma unroll
        for (int s = 0; s < 8; ++s) den += PP[t * 8 + s];
        float wi = wint[0], mtt = mt[0];
#pragma unroll
        for (int u = 1; u < 8; ++u) { wi = (t == u) ? wint[u] : wi; mtt = (t == u) ? mt[u] : mtt; }
        den += wi * ((QN[t] + QN[8 + t]) + (QN[16 + t] + QN[24 + t]));
        ((float*)(p.ws + WS_DEN))[(tok0 + t) * 4 + h] = den; ((float*)(p.ws + WS_MT))[(tok0 + t) * 4 + h] = mtt;
        if (t == 0) p.out[O_MS + bh] = m_new; }
    { const int cgid = tid % CG, rg = tid / CG, col = cgid * 4;
        const float* __restrict__ src = (IS_ML ? p.C0 : p.S0) + (size_t)bh * K * V + col;
        float* __restrict__ dst = p.out + (IS_ML ? O_CS : O_SS) + (size_t)bh * K * V + col;
        f32x4 acc[8], vv[8];
#pragma unroll
        for (int t = 0; t < 8; ++t) { acc[t] = (f32x4){0.f, 0.f, 0.f, 0.f}; vv[t] = *(const LAS f32x4*)(VV + t * V + col); }
        for (int r0 = 0; r0 < NR; r0 += U) {
            f32x4 cv[U];
#pragma unroll
            for (int u = 0; u < U; ++u) cv[u] = __builtin_nontemporal_load((const f32x4*)(src + (size_t)(rg + RG * (r0 + u)) * V));
#pragma unroll
            for (int u = 0; u < U; ++u) { const int k = rg + RG * (r0 + u);
                const f32x4 q0 = *(const LAS f32x4*)(A16 + k * 16), q1 = *(const LAS f32x4*)(A16 + k * 16 + 4), k0 = *(const LAS f32x4*)(A16 + k * 16 + 8), k1 = *(const LAS f32x4*)(A16 + k * 16 + 12);
                const float dec = IS_ML ? decay : DEC[k];
                f32x4 cn = cv[u] * dec;
#pragma unroll
                for (int t = 0; t < 4; ++t) { acc[t] += cv[u] * q0[t]; acc[4 + t] += cv[u] * q1[t]; cn += vv[t] * k0[t]; cn += vv[4 + t] * k1[t]; }
                __builtin_nontemporal_store(cn, (f32x4*)(dst + (size_t)k * V));
                __builtin_amdgcn_sched_barrier(0); }
        }
#pragma unroll
        for (int t = 0; t < 8; ++t) *(LAS f32x4*)(RED + (rg * 8 + t) * V + col) = acc[t];
    }
    __syncthreads();
    { float* OUT = (float*)(p.ws + (IS_ML ? WS_HA : WS_OB));
        for (int idx = tid; idx < 8 * CG; idx += 512) { const int t = idx / CG, col = (idx % CG) * 4;
            f32x4 sacc = (f32x4){0.f, 0.f, 0.f, 0.f};
#pragma unroll
            for (int r = 0; r < RG; ++r) sacc += *(const LAS f32x4*)(RED + (r * 8 + t) * V + col);
            if (IS_ML) { float wi = wint[0];
#pragma unroll
                for (int u = 1; u < 8; ++u) wi = (t == u) ? wint[u] : wi;
                sacc *= wi; }
#pragma unroll
            for (int s = 0; s < 8; ++s) sacc += *(const LAS f32x4*)(VV + s * V + col) * PP[t * 8 + s];
            *(f32x4*)(OUT + (tok0 + t) * D + h * V + col) = sacc; } }
    __syncthreads();
}

constexpr int N_ML_CHAIN = 80, N_HG_CHAIN = 64, N_ML_STREAM = 512, N_HG_STREAM = 1024;
constexpr int N_REC_ITEMS = N_ML_CHAIN + N_HG_CHAIN + N_ML_STREAM + N_HG_STREAM;
#ifndef RECMASK
#define RECMASK 15
#endif
__device__ __forceinline__ int queue_next(unsigned* ctr, LAS int* slot) {
    if (threadIdx.x == 0) *slot = (int)atomicAdd(ctr, 1u);
    __syncthreads();
    const int it = *slot;
    __syncthreads();
    return it;
}
__device__ __forceinline__ void phase_rec(const Params& p, LAS unsigned char* lds, int cbase) {
    unsigned* ctr = (unsigned*)(p.ws + WS_CTL) + cbase;
    LAS int* slot = (LAS int*)(lds + LDS_BYTES - 16);
    if (RECMASK & 1) for (;;) { const int it = queue_next(ctr + 0, slot); if (it >= N_ML_CHAIN) break; chain_item<true>(p, lds, it / 5, it % 5); }
    if (RECMASK & 2) for (;;) { const int it = queue_next(ctr + 1, slot); if (it >= N_HG_CHAIN) break; chain_item<false>(p, lds, it >> 1, it & 1); }
    if (RECMASK & 4) for (;;) { const int it = queue_next(ctr + 2, slot); if (it >= N_ML_STREAM) break; stream_item<true>(p, lds, it); }
    if (RECMASK & 8) for (;;) { const int it = queue_next(ctr + 3, slot); if (it >= N_HG_STREAM) break; stream_item<false>(p, lds, it); }
}

__device__ __forceinline__ void phase_branch(const Params& p) {
    const int lane = threadIdx.x & 63, gw = blockIdx.x * 8 + (threadIdx.x >> 6), NGW = gridDim.x * 8;
    const bf16_t* proj = (const bf16_t*)(p.ws + WS_PROJ);
    const float* HA = (const float*)(p.ws + WS_HA); const float* OB = (const float*)(p.ws + WS_OB);
    const float* DEN = (const float*)(p.ws + WS_DEN); const float* MT = (const float*)(p.ws + WS_MT);
    bf16_t* BRA = (bf16_t*)(p.ws + WS_BRA); bf16_t* BRB = (bf16_t*)(p.ws + WS_BRB);
    for (int row = gw; row < NT; row += NGW) {
#pragma unroll
        for (int h = 0; h < 4; ++h) {
            const float* hp = HA + (size_t)row * D + h * 512 + lane * 8;
            f32x4 v0 = *(const f32x4*)hp, v1 = *(const f32x4*)(hp + 4);
            const float den = DEN[(size_t)row * 4 + h], mtt = MT[(size_t)row * 4 + h];
            const float inv = 1.f / fmaxf(fabsf(den), expf(-mtt));
            v0 *= inv; v1 *= inv;
            const float mu = wave_sum((v0[0] + v0[1]) + (v0[2] + v0[3]) + (v1[0] + v1[1]) + (v1[2] + v1[3])) * (1.f / 512.f);
            v0 -= mu; v1 -= mu;
            const float var = wave_sum((v0[0] * v0[0] + v0[1] * v0[1]) + (v0[2] * v0[2] + v0[3] * v0[3]) + (v1[0] * v1[0] + v1[1] * v1[1]) + (v1[2] * v1[2] + v1[3] * v1[3])) * (1.f / 512.f);
            const float rstd = 1.f / sqrtf(var + LN_EPS);
            const f32x4 g0 = *(const f32x4*)(p.mlg + h * 512 + lane * 8), g1 = *(const f32x4*)(p.mlg + h * 512 + lane * 8 + 4);
            const u32x4 ov = *(const u32x4*)(proj + (size_t)row * NP + C_MLO + h * 512 + lane * 8);
            const float og[8] = {bflo(ov.x), bfhi(ov.x), bflo(ov.y), bfhi(ov.y), bflo(ov.z), bfhi(ov.z), bflo(ov.w), bfhi(ov.w)};
            float r[8];
#pragma unroll
            for (int e = 0; e < 4; ++e) { r[e] = v0[e] * rstd * g0[e] * sigmoidf_(og[e]); r[4 + e] = v1[e] * rstd * g1[e] * sigmoidf_(og[4 + e]); }
            u32x4 o; o.x = pk2(r[0], r[1]); o.y = pk2(r[2], r[3]); o.z = pk2(r[4], r[5]); o.w = pk2(r[6], r[7]);
            *(u32x4*)(BRA + (size_t)row * D + h * 512 + lane * 8) = o;
        }
#pragma unroll
        for (int h = 0; h < 8; ++h) {
            const f32x4 v = *(const f32x4*)(OB + (size_t)row * D + h * 256 + lane * 4);
            const float ms = wave_sum((v[0] * v[0] + v[1] * v[1]) + (v[2] * v[2] + v[3] * v[3])) * (1.f / 256.f);
            const float rstd = 1.f / sqrtf(ms + LN_EPS);
            const f32x4 g = *(const f32x4*)(p.hgg + h * 256 + lane * 4);
            const u32x2 gv = *(const u32x2*)(proj + (size_t)row * NP + C_HGG + h * 256 + lane * 4);
            const float gg[4] = {bflo(gv.x), bfhi(gv.x), bflo(gv.y), bfhi(gv.y)};
            float r[4];
#pragma unroll
            for (int e = 0; e < 4; ++e) r[e] = v[e] * rstd * g[e] * gg[e] * sigmoidf_(gg[e]);
            u32x2 o; o.x = pk2(r[0], r[1]); o.y = pk2(r[2], r[3]);
            *(u32x2*)(BRB + (size_t)row * D + h * 256 + lane * 4) = o;
        }
    }
}

template <bool FIRST>
__device__ __forceinline__ void phase_ln(const bf16_t* Z, const float* RTF, const bf16_t* RTH, const bf16_t* PT, const float* gam, const float* bet, float* OF, bf16_t* OBF) {
    const int lane = threadIdx.x & 63, gw = blockIdx.x * 8 + (threadIdx.x >> 6), NGW = gridDim.x * 8;
    for (int row = gw; row < NT; row += NGW) {
        f32x4 v[8]; float s = 0.f;
        if (row < NTP) { const u32x2* zr = (const u32x2*)(Z + (size_t)row * D);
#pragma unroll
            for (int j = 0; j < 8; ++j) { const u32x2 h = zr[lane + 64 * j]; v[j] = (f32x4){bflo(h.x), bfhi(h.x), bflo(h.y), bfhi(h.y)}; } }
        else {
            if (FIRST) { const f32x4* rr = (const f32x4*)(RTF + (size_t)(row - NTP) * D);
#pragma unroll
                for (int j = 0; j < 8; ++j) v[j] = rr[lane + 64 * j] * ALPHA; }
            else { const u32x2* rr = (const u32x2*)(RTH + (size_t)row * D);
#pragma unroll
                for (int j = 0; j < 8; ++j) { const u32x2 h = rr[lane + 64 * j]; v[j] = (f32x4){bflo(h.x), bfhi(h.x), bflo(h.y), bfhi(h.y)} * ALPHA; } }
#pragma unroll
            for (int sidx = 0; sidx < 8; ++sidx) { const u32x2* pr = (const u32x2*)(PT + ((size_t)sidx * NTS + (row - NTP)) * D);
#pragma unroll
                for (int j = 0; j < 8; ++j) { const u32x2 h = pr[lane + 64 * j]; v[j] += (f32x4){bflo(h.x), bfhi(h.x), bflo(h.y), bfhi(h.y)}; } } }
#pragma unroll
        for (int j = 0; j < 8; ++j) s += (v[j][0] + v[j][1]) + (v[j][2] + v[j][3]);
        const float mu = wave_sum(s) * (1.f / D); float s2 = 0.f;
#pragma unroll
        for (int j = 0; j < 8; ++j) { v[j] -= mu; s2 += (v[j][0] * v[j][0] + v[j][1] * v[j][1]) + (v[j][2] * v[j][2] + v[j][3] * v[j][3]); }
        const float rstd = 1.f / sqrtf(wave_sum(s2) * (1.f / D) + LN_EPS);
#pragma unroll
        for (int j = 0; j < 8; ++j) { const f32x4 g = ((const f32x4*)gam)[lane + 64 * j], bb = ((const f32x4*)bet)[lane + 64 * j];
            const f32x4 o = v[j] * rstd * g + bb;
            if (FIRST) { u32x2 ob; ob.x = pk2(o[0], o[1]); ob.y = pk2(o[2], o[3]); ((u32x2*)(OBF + (size_t)row * D))[lane + 64 * j] = ob; }
            else ((f32x4*)(OF + (size_t)row * D))[lane + 64 * j] = o; }
    }
}

constexpr int N_PHASES = 10;
#ifndef PHMASK
#define PHMASK 1023
#endif
#ifndef PROBE_DUP
#define PROBE_DUP -1
#endif
#define PH_BEGIN(k) if ((k) > p.ph_lo && (k) < p.ph_hi) xcd_barrier(xb); if ((PHMASK & (1 << (k))) && (k) >= p.ph_lo && (k) < p.ph_hi)
__global__ void __launch_bounds__(512, 2) mega(Params p) {
    extern __shared__ __attribute__((aligned(16))) unsigned char shm[];
    LAS unsigned char* lds = (LAS unsigned char*)shm;
    cg::grid_group grid = cg::this_grid();
    if (p.ph_lo < 0) grid.sync();
    volatile LAS unsigned* xst = (volatile LAS unsigned*)(lds + LDS_BYTES - 32);
    if (threadIdx.x == 0) { xst[0] = 0u; xst[1] = 0u; }
    __syncthreads();
    const XcdBarrier xb = xcd_barrier_post((unsigned*)(p.ws + WS_BAR), xst);
    PH_BEGIN(0) phase_prep(p, lds);
    PH_BEGIN(1) { pg8::StaticOrder S; S.init(NT, NP, D, gridDim.x, blockIdx.x); pg8::Gemm g{(const bf16_t*)(p.ws + WS_XB), (const bf16_t*)(p.ws + WS_WIN), NT, NP, D};
        pg8::EpiProj E{(bf16_t*)(p.ws + WS_PROJ), NP}; pg8::gemm_phase(lds, g, S, E); }
    PH_BEGIN(2) phase_rec(p, lds, 0);
    PH_BEGIN(3) phase_branch(p);
    PH_BEGIN(4) {
        pg8::TailOrder S; S.init(D, gridDim.x, blockIdx.x);
        { pg8::Gemm g{(const bf16_t*)(p.ws + WS_BRA), (const bf16_t*)(p.ws + WS_WA), NT, D, D};
            pg8::EpiMerge<0> E{(const bf16_t*)(p.ws + WS_PROJ), (float*)(p.ws + WS_TMP), (bf16_t*)(p.ws + WS_MRG), (bf16_t*)(p.ws + WS_PART)}; pg8::gemm_phase(lds, g, S, E); }
        __syncthreads();
        { pg8::Gemm g{(const bf16_t*)(p.ws + WS_BRB), (const bf16_t*)(p.ws + WS_WB), NT, D, D};
            pg8::EpiMerge<1> E{(const bf16_t*)(p.ws + WS_PROJ), (float*)(p.ws + WS_TMP), (bf16_t*)(p.ws + WS_MRG), (bf16_t*)(p.ws + WS_PART)}; pg8::gemm_phase(lds, g, S, E); }
        xcd_barrier(xb);
        { const u32x2* tz = (const u32x2*)(p.ws + WS_PART); u32x2* mo = (u32x2*)((bf16_t*)(p.ws + WS_MRG) + (size_t)NTP * D);
            for (int i = blockIdx.x * 512 + threadIdx.x; i < NTS * D / 4; i += gridDim.x * 512) { f32x4 v = (f32x4){0.f, 0.f, 0.f, 0.f};
#pragma unroll
                for (int sidx = 0; sidx < 8; ++sidx) { const u32x2 h = tz[(size_t)sidx * (NTS * D / 4) + i]; v += (f32x4){bflo(h.x), bfhi(h.x), bflo(h.y), bfhi(h.y)}; }
                u32x2 o; o.x = pk2(v[0], v[1]); o.y = pk2(v[2], v[3]); mo[i] = o; } }
    }
    PH_BEGIN(5) { pg8::TailOrder S; S.init(D, gridDim.x, blockIdx.x); pg8::Gemm g{(const bf16_t*)(p.ws + WS_MRG), (const bf16_t*)(p.ws + WS_WOUT), NT, D, D};
        pg8::EpiRes<false> E{p.xp, p.xs, nullptr, NTP, (bf16_t*)(p.ws + WS_Z1), (bf16_t*)(p.ws + WS_PART)}; pg8::gemm_phase(lds, g, S, E); }
    PH_BEGIN(6) phase_ln<true>((const bf16_t*)(p.ws + WS_Z1), p.xs, nullptr, (const bf16_t*)(p.ws + WS_PART), p.ln1g, p.ln1b, nullptr, (bf16_t*)(p.ws + WS_X1B));
    PH_BEGIN(7) { pg8::StaticOrder S; S.init(NT, DFF, D, gridDim.x, blockIdx.x); pg8::Gemm g{(const bf16_t*)(p.ws + WS_X1B), (const bf16_t*)(p.ws + WS_WUP), NT, DFF, D};
        pg8::EpiHid E{(bf16_t*)(p.ws + WS_HID), DFF}; pg8::gemm_phase(lds, g, S, E); }
    PH_BEGIN(8) { pg8::TailOrder S; S.init(DFF, gridDim.x, blockIdx.x); pg8::Gemm g{(const bf16_t*)(p.ws + WS_HID), (const bf16_t*)(p.ws + WS_WDN), NT, D, DFF};
        pg8::EpiRes<true> E{nullptr, nullptr, (const bf16_t*)(p.ws + WS_X1B), NT, (bf16_t*)(p.ws + WS_Z2), (bf16_t*)(p.ws + WS_PART)}; pg8::gemm_phase(lds, g, S, E); }
    PH_BEGIN(9) phase_ln<false>((const bf16_t*)(p.ws + WS_Z2), nullptr, (const bf16_t*)(p.ws + WS_X1B), (const bf16_t*)(p.ws + WS_PART), p.ln2g, p.ln2b, p.out + O_Y, nullptr);
}

#ifndef MK_MULTI
#define MK_MULTI 0
#endif
extern "C" void kernel_launch(void* const* d_in, const int* in_sizes, int n_in, void* d_out, int out_size, void* d_ws, size_t ws_size, hipStream_t stream) {
    static int grid = 0;
    if (grid == 0) {
        int dev = 0, cus = 0, per = 0;
        if (n_in != 21 || ws_size < WS_END) { fprintf(stderr, "kernel_launch: unexpected n_in %d / ws_size %zu (need %zu)\n", n_in, ws_size, (size_t)WS_END); grid = -1; return; }
        (void)hipGetDevice(&dev);
        (void)hipDeviceGetAttribute(&cus, hipDeviceAttributeMultiprocessorCount, dev);
        (void)hipFuncSetAttribute((const void*)mega, hipFuncAttributeMaxDynamicSharedMemorySize, LDS_BYTES);
        (void)hipOccupancyMaxActiveBlocksPerMultiprocessor(&per, (const void*)mega, 512, LDS_BYTES);
        if (per < 1) { fprintf(stderr, "kernel_launch: occupancy query says %d blocks per CU\n", per); per = 1; }
        grid = cus;
    }
    if (grid < 0) return;
    (void)hipMemsetAsync((char*)d_ws + WS_CTL, 0, 32768, stream);
    Params p{};
    const float** pp = (const float**)&p;
    for (int i = 0; i < 21; ++i) pp[i] = (const float*)d_in[i];
    p.out = (float*)d_out; p.ws = (unsigned char*)d_ws; p.rep = 2;
#if MK_MULTI
    for (int ph = 0; ph < N_PHASES; ++ph) { p.ph_lo = ph; p.ph_hi = ph + 1; hipLaunchKernelGGL(mega, dim3(grid), dim3(512), LDS_BYTES, stream, p); }
#else
    p.ph_lo = 0; p.ph_hi = N_PHASES;
    void* args[] = {&p};
    hipError_t e = hipLaunchCooperativeKernel((const void*)mega, dim3(grid), dim3(512), args, LDS_BYTES, stream);
    if (e != hipSuccess) fprintf(stderr, "kernel_launch: cooperative launch failed: %s (grid %d)\n", hipGetErrorString(e), grid);
#endif
}
```

```cpp
#include <hip/hip_runtime.h>
#include <hip/hip_cooperative_groups.h>
#include <cstdio>
#include <cstdint>
namespace cg = cooperative_groups;

#define LAS __attribute__((address_space(3)))
typedef unsigned short bf16_t;
typedef short bf16x8 __attribute__((ext_vector_type(8)));
typedef short bf16x4 __attribute__((ext_vector_type(4)));
typedef float f32x4 __attribute__((ext_vector_type(4)));
typedef float f32x2 __attribute__((ext_vector_type(2)));
typedef unsigned u32x4 __attribute__((ext_vector_type(4)));
typedef unsigned u32x2 __attribute__((ext_vector_type(2)));

constexpr int D = 2048, NTP = 8192, NTS = 1024, NT = 9216, DIN = 16392, NP = 16384, DFF = 8192;
constexpr int C_MLQ = 0, C_MLK = 1024, C_MLV = 2048, C_MLO = 4096, C_HGQ = 6144, C_HGF = 7168, C_HGI = 8192, C_HGG = 10240, C_GA = 12288, C_GB = 14336;
constexpr float LN_EPS = 1e-5f;
constexpr float ALPHA = 1.189207115002721f;
constexpr size_t O_Y = 0, O_CP = 18874368, O_NP = 20971520, O_MP = 20975616, O_SP = 20975632, O_CS = 22024208, O_NS = 89133072, O_MS = 89264144, O_SS = 89264656;
constexpr size_t WS_CTL = 0;
constexpr size_t WS_BAR = 4096;
constexpr size_t WS_WIN = 32768;
constexpr size_t WS_WA = WS_WIN + (size_t)NP * D * 2;
constexpr size_t WS_WB = WS_WA + (size_t)D * D * 2;
constexpr size_t WS_WOUT = WS_WB + (size_t)D * D * 2;
constexpr size_t WS_WUP = WS_WOUT + (size_t)D * D * 2;
constexpr size_t WS_WDN = WS_WUP + (size_t)DFF * D * 2;
constexpr size_t WS_XB = WS_WDN + (size_t)DFF * D * 2;
constexpr size_t WS_GATES = WS_XB + (size_t)NT * D * 2;
constexpr size_t WS_DEN = WS_GATES + (size_t)NT * 8 * 4;
constexpr size_t WS_MT = WS_DEN + (size_t)NT * 4 * 4;
constexpr size_t WS_PROJ = WS_MT + (size_t)NT * 4 * 4;
constexpr size_t WS_HA = WS_PROJ + (size_t)NT * NP * 2;
constexpr size_t WS_OB = WS_HA + (size_t)NT * D * 4;
constexpr size_t WS_BRA = WS_OB + (size_t)NT * D * 4;
constexpr size_t WS_BRB = WS_BRA + (size_t)NT * D * 2;
constexpr size_t WS_MRG = WS_BRB + (size_t)NT * D * 2;
constexpr size_t WS_PART = WS_MRG + (size_t)NT * D * 2;
constexpr size_t WS_GSCAN = WS_PART + (size_t)16 * NTS * D * 4;
constexpr size_t WS_END = WS_GSCAN + (size_t)NTP * 16 * 4;
constexpr size_t WS_TMP = WS_HA;
constexpr size_t WS_Z1 = WS_OB;
constexpr size_t WS_X1F = WS_PROJ;
constexpr size_t WS_X1B = WS_X1F + (size_t)NT * D * 4;
constexpr size_t WS_HID = WS_X1B + (size_t)NT * D * 2;
constexpr size_t WS_Z2 = WS_HA;
static_assert(WS_HID + (size_t)NT * DFF * 2 <= WS_HA, "overlay overflow");

constexpr int LDS_BYTES = 163840;

struct Params {
    const float *xp, *xs, *C0, *n0, *m0, *S0, *lbl, *w_in, *b_ig, *b_fg, *mlg, *hgg, *w_a, *w_b, *w_out, *ln1g, *ln1b, *w_up, *w_dn, *ln2g, *ln2b;
    float* out; unsigned char* ws;
    int ph_lo, ph_hi, rep, pad_;
};

__device__ __forceinline__ unsigned pk2(float lo, float hi) { unsigned r; asm("v_cvt_pk_bf16_f32 %0, %1, %2" : "=v"(r) : "v"(lo), "v"(hi)); return r; }
__device__ __forceinline__ float bflo(unsigned u) { return __uint_as_float(u << 16); }
__device__ __forceinline__ float bfhi(unsigned u) { return __uint_as_float(u & 0xffff0000u); }
__device__ __forceinline__ float bf1(unsigned short b) { return __uint_as_float(((unsigned)b) << 16); }
__device__ __forceinline__ float sigmoidf_(float x) { return __builtin_amdgcn_rcpf(1.f + __expf(-x)); }
__device__ __forceinline__ float wave_sum(float v) {
#pragma unroll
    for (int o = 1; o < 64; o <<= 1) v += __shfl_xor(v, o);
    return v;
}
#define LDS_WAIT() asm volatile("s_waitcnt lgkmcnt(0)" ::: "memory")
#define LDS_BAR() do { asm volatile("s_waitcnt lgkmcnt(0)" ::: "memory"); __builtin_amdgcn_s_barrier(); asm volatile("" ::: "memory"); } while (0)


#define XB_TMO      128
#define XB_XCNT(j)  (256  + 64 * (j))
#define XB_XSUB(j)  (1280 + 64 * (j))
#define XB_XGEN(j)  (2304 + 64 * (j))
#define XB_TOP      3328
#define XB_TOPGEN   3392
#define XCD_BAR_WORDS 3456
#define XB_SPIN_CAP (1u << 22)
__device__ __forceinline__ unsigned xb_ld(unsigned* p)              { return __hip_atomic_load(p, __ATOMIC_RELAXED, __HIP_MEMORY_SCOPE_AGENT); }
__device__ __forceinline__ unsigned xb_add(unsigned* p, unsigned v) { return __hip_atomic_fetch_add(p, v, __ATOMIC_RELAXED, __HIP_MEMORY_SCOPE_AGENT); }
__device__ __forceinline__ unsigned xb_xcc_id() { return (unsigned)__builtin_amdgcn_s_getreg((3 << 11) | 20) & 0xFu; }
#define XB_SPIN(cond, bar) do { unsigned _sp = 0; while (cond) { __builtin_amdgcn_s_sleep(1); \
    if ((++_sp & 255u) == 0u) { if (xb_ld(&(bar)[XB_TMO])) break; if (_sp > XB_SPIN_CAP) { atomicAdd(&(bar)[XB_TMO], 1u); break; } } } } while (0)
struct XcdBarrier { unsigned* bar; unsigned x; volatile LAS unsigned* st; };
__device__ __forceinline__ XcdBarrier xcd_barrier_post(unsigned* bar, volatile LAS unsigned* st) {
    XcdBarrier b; b.bar = bar; b.x = xb_xcc_id(); b.st = st;
    if (threadIdx.x == 0) (void)xb_add(&bar[XB_XCNT(b.x)], 1u);
    return b;
}
__device__ __forceinline__ void xcd_barrier_complete(unsigned* bar, unsigned x, unsigned& nloc, unsigned& nx) {
    const unsigned G = gridDim.x * gridDim.y * gridDim.z;
    unsigned sum, cnt, mine, sp = 0u;
    for (;;) {
        sum = 0u; cnt = 0u; mine = 0u;
#pragma unroll
        for (unsigned j = 0; j < 16; ++j) { const unsigned c = xb_ld(&bar[XB_XCNT(j)]); sum += c; cnt += (c > 0u) ? 1u : 0u; mine = (j == x) ? c : mine; }
        if (sum == G) break;
        __builtin_amdgcn_s_sleep(1);
        if ((++sp & 255u) == 0u) { if (xb_ld(&bar[XB_TMO])) break; if (sp > XB_SPIN_CAP) { atomicAdd(&bar[XB_TMO], 1u); break; } }
    }
    nloc = mine > 0u ? mine : 1u; nx = cnt > 0u ? cnt : 1u;
}
__device__ __forceinline__ void xcd_barrier(const XcdBarrier& b) {
    asm volatile("s_waitcnt vmcnt(0)" ::: "memory");
    __syncthreads();
    if (threadIdx.x == 0) {
        unsigned* bar = b.bar;
        __builtin_amdgcn_s_waitcnt(0);
        unsigned nloc = b.st[0], nx = b.st[1];
        if (nloc == 0u) { xcd_barrier_complete(bar, b.x, nloc, nx); b.st[0] = nloc; b.st[1] = nx; }
        const unsigned old = xb_add(&bar[XB_XSUB(b.x)], 1u);
        const unsigned gen = old / nloc;
        if (old + 1u == (gen + 1u) * nloc) {
            __builtin_amdgcn_fence(__ATOMIC_RELEASE, "agent");
            asm volatile("s_waitcnt vmcnt(0)" ::: "memory");
            const unsigned og = xb_add(&bar[XB_TOP], 1u);
            const unsigned tg = og / nx;
            if (og + 1u == (tg + 1u) * nx) xb_add(&bar[XB_TOPGEN], 1u);
            else XB_SPIN(xb_ld(&bar[XB_TOPGEN]) == tg, bar);
            __builtin_amdgcn_fence(__ATOMIC_ACQUIRE, "agent");
            xb_add(&bar[XB_XGEN(b.x)], 1u);
            asm volatile("s_waitcnt vmcnt(0)" ::: "memory");
        } else {
            XB_SPIN(xb_ld(&bar[XB_XGEN(b.x)]) == gen, bar);
            __builtin_amdgcn_fence(__ATOMIC_ACQUIRE, "agent");
            asm volatile("s_waitcnt vmcnt(0)" ::: "memory");
        }
    }
    __syncthreads();
}

namespace pg8 {
#define PG8_LAS __attribute__((address_space(3)))
constexpr int BM = 256, BK = 64, HALF = 128, HTB = HALF * BK * 2, STAGE_BYTES = 8 * HTB, NXCD = 8, WGM = 8;
__host__ __device__ __forceinline__ int lds_byte(int r, int c) { const int st = (r >> 4) * 2 + (c >> 5), rr = r & 15, cc = c & 31, ob = rr * 64 + cc * 2; return st * 1024 + (ob ^ (((ob >> 9) & 1) << 5)); }
__host__ __device__ __forceinline__ void stage_rc(int b, int& R, int& C) { const int st = b / 1024, sb = b % 1024, swz = sb ^ (((sb >> 9) & 1) << 5); R = (st >> 1) * 16 + swz / 64; C = (st & 1) * 32 + (swz % 64) / 2; }
__host__ __device__ __forceinline__ int perm32(int rho) { const int n = rho >> 4, i = rho & 15; return 8 * (i >> 2) + 4 * n + (i & 3); }
struct Unit { int pm, pn, k0, nt, mode; };
struct Gemm { const bf16_t* A; const bf16_t* Bt; int M, N, K; };
struct StaticOrder {
    int nM, nN, nwg, G, c, ntk;
    __host__ __device__ void init(int M, int N, int K, int G_, int c_) { nM = M / BM; nN = N / BM; nwg = nM * nN; G = G_; c = c_; ntk = K / BK; }
    __host__ __device__ void map(int wgid, Unit& u) const {
        { const int q = nwg / NXCD, r = nwg % NXCD, xcd = wgid % NXCD, off = wgid / NXCD; wgid = (xcd < r ? xcd * (q + 1) : r * (q + 1) + (xcd - r) * q) + off; }
        const int nig = WGM * nN, gid = wgid / nig, fm = gid * WGM, gsz = (nM - fm) < WGM ? (nM - fm) : WGM;
        u.pm = fm + ((wgid % nig) % gsz); u.pn = (wgid % nig) / gsz; u.k0 = 0; u.nt = ntk; u.mode = 0;
    }
    __host__ __device__ bool next(int i, Unit& u) const {
        const long L = (long)i * G + c; if (L >= nwg) return false;
        map((int)L, u); return true;
    }
    __device__ __forceinline__ void a_ready(const Unit&) const {}
    __device__ __forceinline__ void done(const Unit&) const {}
};
struct TailOrder : StaticOrder {
    int nsub, ksub;
    __host__ __device__ void init(int K, int G_, int c_) { StaticOrder::init(8192, 2048, K, G_, c_); nsub = 256; ksub = K / 8; }
    __host__ __device__ bool next(int i, Unit& u) const {
        const long L = (long)i * G + c;
        if (L < nwg) { map((int)L, u); return true; }
        const int j = (int)(L - nwg); if (j >= nsub) return false;
        const int uu = j >> 3, ks = j & 7;
        u.pm = 32 + (uu & 3); u.pn = uu >> 2; u.k0 = ks * ksub; u.nt = ksub / BK; u.mode = 1 + ks; return true;
    }
};
struct EpiProj {
    static constexpr bool PERM = true, AFTER_DRAIN = false;
    bf16_t* O; int ldc;
    __device__ __forceinline__ void operator()(const f32x4 (&acc)[2][2][4][2], const Unit& u, int wr, int wc, int fr, int fq) const {
        const int row0 = u.pm * BM + wr * 64 + fr, col0 = u.pn * BM + wc * 32 + 8 * fq;
#pragma unroll
        for (int ai = 0; ai < 2; ++ai)
#pragma unroll
            for (int m = 0; m < 4; ++m) { bf16_t* rowp = O + (size_t)(row0 + ai * HALF + m * 16) * ldc + col0;
#pragma unroll
                for (int bj = 0; bj < 2; ++bj) { const f32x4 v0 = acc[ai][bj][m][0], v1 = acc[ai][bj][m][1];
                    u32x4 o; o.x = pk2(v0[0], v0[1]); o.y = pk2(v0[2], v0[3]); o.z = pk2(v1[0], v1[1]); o.w = pk2(v1[2], v1[3]);
                    *(u32x4*)(rowp + bj * HALF) = o; } }
    }
};
struct EpiHid {
    static constexpr bool PERM = true, AFTER_DRAIN = false;
    bf16_t* O; int ldc;
    __device__ __forceinline__ void operator()(const f32x4 (&acc)[2][2][4][2], const Unit& u, int wr, int wc, int fr, int fq) const {
        const int row0 = u.pm * BM + wr * 64 + fr, col0 = u.pn * BM + wc * 32 + 8 * fq;
#pragma unroll
        for (int ai = 0; ai < 2; ++ai)
#pragma unroll
            for (int m = 0; m < 4; ++m) { bf16_t* rowp = O + (size_t)(row0 + ai * HALF + m * 16) * ldc + col0;
#pragma unroll
                for (int bj = 0; bj < 2; ++bj) { f32x4 v0 = acc[ai][bj][m][0], v1 = acc[ai][bj][m][1];
#pragma unroll
                    for (int e = 0; e < 4; ++e) { const float a = fmaxf(v0[e], 0.f), b = fmaxf(v1[e], 0.f); v0[e] = a * a; v1[e] = b * b; }
                    u32x4 o; o.x = pk2(v0[0], v0[1]); o.y = pk2(v0[2], v0[3]); o.z = pk2(v1[0], v1[1]); o.w = pk2(v1[2], v1[3]);
                    *(u32x4*)(rowp + bj * HALF) = o; } }
    }
};
template <int PASS> struct EpiMerge {
    static constexpr bool PERM = true, AFTER_DRAIN = false;
    const bf16_t* proj; bf16_t* tmp; bf16_t* O; bf16_t* tmpT;
    __device__ __forceinline__ void operator()(const f32x4 (&acc)[2][2][4][2], const Unit& u, int wr, int wc, int fr, int fq) const {
        const int row0 = u.pm * BM + wr * 64 + fr, col0 = u.pn * BM + wc * 32 + 8 * fq;
        const bool part = u.mode != 0;
#pragma unroll
        for (int ai = 0; ai < 2; ++ai)
#pragma unroll
            for (int m = 0; m < 4; ++m) { const size_t row = (size_t)(row0 + ai * HALF + m * 16);
#pragma unroll
                for (int bj = 0; bj < 2; ++bj) { const int col = col0 + bj * HALF;
                    const u32x4 gv = *(const u32x4*)(proj + row * NP + (PASS == 0 ? C_GA : C_GB) + col);
                    f32x4 s0, s1;
                    s0[0] = sigmoidf_(bflo(gv.x)); s0[1] = sigmoidf_(bfhi(gv.x)); s0[2] = sigmoidf_(bflo(gv.y)); s0[3] = sigmoidf_(bfhi(gv.y));
                    s1[0] = sigmoidf_(bflo(gv.z)); s1[1] = sigmoidf_(bfhi(gv.z)); s1[2] = sigmoidf_(bflo(gv.w)); s1[3] = sigmoidf_(bfhi(gv.w));
                    f32x4 v0 = acc[ai][bj][m][0] * s0, v1 = acc[ai][bj][m][1] * s1;
                    if (part) { bf16_t* tp = tmpT + ((size_t)(u.mode - 1) * NTS + (row - NTP)) * D + col;
                        if (PASS == 1) { const u32x4 pv = *(const u32x4*)tp; v0 += (f32x4){bflo(pv.x), bfhi(pv.x), bflo(pv.y), bfhi(pv.y)}; v1 += (f32x4){bflo(pv.z), bfhi(pv.z), bflo(pv.w), bfhi(pv.w)}; }
                        u32x4 o; o.x = pk2(v0[0], v0[1]); o.y = pk2(v0[2], v0[3]); o.z = pk2(v1[0], v1[1]); o.w = pk2(v1[2], v1[3]); *(u32x4*)tp = o; }
                    else { bf16_t* tp = tmp + row * D + col;
                        if (PASS == 0) { u32x4 o; o.x = pk2(v0[0], v0[1]); o.y = pk2(v0[2], v0[3]); o.z = pk2(v1[0], v1[1]); o.w = pk2(v1[2], v1[3]); *(u32x4*)tp = o; }
                        else { const u32x4 pv = *(const u32x4*)tp; v0 += (f32x4){bflo(pv.x), bfhi(pv.x), bflo(pv.y), bfhi(pv.y)}; v1 += (f32x4){bflo(pv.z), bfhi(pv.z), bflo(pv.w), bfhi(pv.w)};
                            u32x4 o; o.x = pk2(v0[0], v0[1]); o.y = pk2(v0[2], v0[3]); o.z = pk2(v1[0], v1[1]); o.w = pk2(v1[2], v1[3]);
                            *(u32x4*)(O + row * D + col) = o; } }
                    __builtin_amdgcn_sched_barrier(0); } }
    }
};
template <bool RES_BF16> struct EpiRes {
    static constexpr bool PERM = false, AFTER_DRAIN = false;
    const float* rA; const float* rB; const bf16_t* rH; int split; bf16_t* Z; bf16_t* PT;
    __device__ __forceinline__ void operator()(const f32x4 (&acc)[2][2][4][2], const Unit& u, int wr, int wc, int fr, int fq) const {
        const int row0 = u.pm * BM + wr * 64 + fr, col0 = u.pn * BM + wc * 32 + 4 * fq;
        const bool part = u.mode != 0;
#pragma unroll
        for (int ai = 0; ai < 2; ++ai)
#pragma unroll
            for (int m = 0; m < 4; ++m) { const int row = row0 + ai * HALF + m * 16;
                const float* rp = (row < split ? rA + (size_t)row * D : rB + (size_t)(row - split) * D) + col0;
                const bf16_t* hp = rH + (size_t)row * D + col0;
                bf16_t* zp = Z + (size_t)row * D + col0;
#pragma unroll
                for (int bj = 0; bj < 2; ++bj)
#pragma unroll
                    for (int n = 0; n < 2; ++n) {
                        if (part) { const f32x4 a = acc[ai][bj][m][n]; u32x2 o; o.x = pk2(a[0], a[1]); o.y = pk2(a[2], a[3]); *(u32x2*)(PT + ((size_t)(u.mode - 1) * NTS + (row - NTP)) * D + col0 + bj * HALF + n * 16) = o; }
                        else { f32x4 r;
                            if (RES_BF16) { const u32x2 hv = *(const u32x2*)(hp + bj * HALF + n * 16); r = (f32x4){bflo(hv.x), bfhi(hv.x), bflo(hv.y), bfhi(hv.y)}; }
                            else r = *(const f32x4*)(rp + bj * HALF + n * 16);
                            const f32x4 z = r * ALPHA + acc[ai][bj][m][n];
                            u32x2 o; o.x = pk2(z[0], z[1]); o.y = pk2(z[2], z[3]);
                            *(u32x2*)(zp + bj * HALF + n * 16) = o; } } }
    }
};

template <class Epi, class Sched>
__device__ __forceinline__ void gemm_phase(PG8_LAS unsigned char* lds, const Gemm g, const Sched& S, const Epi& E) {
    const int tid = threadIdx.x, wid = __builtin_amdgcn_readfirstlane(tid >> 6), lane = tid & 63, wr = wid >> 2, wc = wid & 3, fr = lane & 15, fq = lane >> 4;
    const int K = g.K;
    unsigned voffA[2], voffB[2];
#pragma unroll
    for (int i = 0; i < 2; ++i) { int R, C; stage_rc(tid * 16 + i * 8192, R, C); const int Rb = Epi::PERM ? ((R & ~31) + perm32(R & 31)) : R;
        voffA[i] = (unsigned)(R * K + C) * 2u; voffB[i] = (unsigned)(Rb * K + C) * 2u; }
    const size_t kstep = (size_t)(BK * 2);
    const size_t hstep = (size_t)HALF * K * 2;
    const size_t tstep = 2 * hstep;
    const unsigned ldsw = (unsigned)wid * 1024u;
    const int aoff = lds_byte(wr * 64 + fr, fq * 8), boff = lds_byte(wc * 32 + fr, fq * 8);
#define PG8_SA(b, h) (((b) * 2 + (h)) * HTB)
#define PG8_SB(b, h) ((4 + (b) * 2 + (h)) * HTB)
#define PG8_STAGE(bufoff, gbase, voff) do { _Pragma("unroll") for (int _i = 0; _i < 2; ++_i) \
        __builtin_amdgcn_global_load_lds((const unsigned*)((const char*)(gbase) + (voff)[_i]), (PG8_LAS unsigned*)(lds + (bufoff) + ldsw + _i * 8192), 16, 0, 0); } while (0)
#define PG8_LDA(dst, b, h) do { _Pragma("unroll") for (int m = 0; m < 4; ++m) _Pragma("unroll") for (int k = 0; k < 2; ++k) dst[m][k] = *(const PG8_LAS bf16x8*)(lds + PG8_SA(b, h) + aoff + m * 2048 + k * 1024); } while (0)
#define PG8_LDB(dst, b, h) do { _Pragma("unroll") for (int n = 0; n < 2; ++n) _Pragma("unroll") for (int k = 0; k < 2; ++k) dst[n][k] = *(const PG8_LAS bf16x8*)(lds + PG8_SB(b, h) + boff + n * 2048 + k * 1024); } while (0)
#define PG8_MMA(ai, bj, At, Bt) do { __builtin_amdgcn_s_setprio(1); _Pragma("unroll") for (int m = 0; m < 4; ++m) _Pragma("unroll") for (int n = 0; n < 2; ++n) _Pragma("unroll") for (int k = 0; k < 2; ++k) \
        acc[ai][bj][m][n] = __builtin_amdgcn_mfma_f32_16x16x32_bf16(Bt[n][k], At[m][k], acc[ai][bj][m][n], 0, 0, 0); __builtin_amdgcn_s_setprio(0); } while (0)
#define PG8_WAIT_V(n) asm volatile("s_waitcnt vmcnt(" #n ")" ::: "memory")
#define PG8_WAIT_L(n) asm volatile("s_waitcnt lgkmcnt(" #n ")" ::: "memory")
#define PG8_BAR __builtin_amdgcn_s_barrier()
#define PG8_SCHED __builtin_amdgcn_sched_barrier(0)
    Unit cur, nxt; int ui = 0;
    if (!S.next(0, cur)) return;
    f32x4 acc[2][2][4][2];
#pragma unroll
    for (int a = 0; a < 2; ++a)
#pragma unroll
        for (int b = 0; b < 2; ++b)
#pragma unroll
            for (int m = 0; m < 4; ++m)
#pragma unroll
                for (int n = 0; n < 2; ++n) acc[a][b][m][n] = (f32x4){0.f, 0.f, 0.f, 0.f};
    bf16x8 At[4][2], B0[2][2], B1[2][2];
    const char* cA = (const char*)g.A + (size_t)cur.pm * tstep + (size_t)cur.k0 * 2; const char* cB = (const char*)g.Bt + (size_t)cur.pn * tstep + (size_t)cur.k0 * 2;
    S.a_ready(cur);
    PG8_STAGE(PG8_SB(0, 0), cB, voffB); PG8_STAGE(PG8_SA(0, 0), cA, voffA); PG8_STAGE(PG8_SB(0, 1), cB + hstep, voffB); PG8_STAGE(PG8_SA(0, 1), cA + hstep, voffA);
    if (wr == 1) PG8_BAR;
    PG8_WAIT_V(4); PG8_BAR;
    PG8_STAGE(PG8_SB(1, 0), cB + kstep, voffB); PG8_STAGE(PG8_SA(1, 0), cA + kstep, voffA); PG8_STAGE(PG8_SB(1, 1), cB + hstep + kstep, voffB);
    PG8_WAIT_V(6); PG8_BAR;
    for (;;) {
        const bool has_next = S.next(ui + 1, nxt);
        const char* nA = has_next ? (const char*)g.A + (size_t)nxt.pm * tstep + (size_t)nxt.k0 * 2 : cA; const char* nB = has_next ? (const char*)g.Bt + (size_t)nxt.pn * tstep + (size_t)nxt.k0 * 2 : cB;
        const int nt = cur.nt;
        for (int t = 0; t < nt; t += 2) {
            const bool last = (t == nt - 2);
            const char* a1 = cA + (size_t)(t + 1) * kstep;
            const char* a2 = last ? nA : cA + (size_t)(t + 2) * kstep; const char* b2 = last ? nB : cB + (size_t)(t + 2) * kstep;
            const char* a3 = a2 + kstep; const char* b3 = b2 + kstep;
            if (last && has_next) S.a_ready(nxt);
            PG8_LDB(B0, 0, 0); PG8_SCHED; PG8_LDA(At, 0, 0); PG8_STAGE(PG8_SA(1, 1), a1 + hstep, voffA);
            PG8_WAIT_L(8); PG8_BAR; PG8_WAIT_L(0); PG8_MMA(0, 0, At, B0); PG8_BAR; PG8_SCHED;
            PG8_LDB(B1, 0, 1); PG8_STAGE(PG8_SB(0, 0), b2, voffB);
            PG8_BAR; PG8_WAIT_L(0); PG8_MMA(0, 1, At, B1); PG8_BAR;
            PG8_LDA(At, 0, 1); PG8_STAGE(PG8_SA(0, 0), a2, voffA);
            PG8_BAR; PG8_WAIT_L(0); PG8_MMA(1, 0, At, B0); PG8_BAR; PG8_SCHED;
            PG8_STAGE(PG8_SB(0, 1), b2 + hstep, voffB);
            PG8_WAIT_V(6); PG8_BAR; PG8_MMA(1, 1, At, B1); PG8_BAR;
            PG8_LDB(B0, 1, 0); PG8_SCHED; PG8_LDA(At, 1, 0); PG8_STAGE(PG8_SA(0, 1), a2 + hstep, voffA);
            PG8_WAIT_L(8); PG8_BAR; PG8_WAIT_L(0); PG8_MMA(0, 0, At, B0); PG8_BAR; PG8_SCHED;
            PG8_LDB(B1, 1, 1); PG8_STAGE(PG8_SB(1, 0), b3, voffB);
            PG8_BAR; PG8_WAIT_L(0); PG8_MMA(0, 1, At, B1); PG8_BAR;
            PG8_LDA(At, 1, 1); PG8_STAGE(PG8_SA(1, 0), a3, voffA);
            PG8_BAR; PG8_WAIT_L(0); PG8_MMA(1, 0, At, B0); PG8_BAR; PG8_SCHED;
            PG8_STAGE(PG8_SB(1, 1), b3 + hstep, voffB);
            PG8_WAIT_V(6); PG8_BAR; PG8_MMA(1, 1, At, B1); PG8_BAR;
        }
        if constexpr (!Epi::AFTER_DRAIN) { E(acc, cur, wr, wc, fr, fq); S.done(cur); }
        if (!has_next) break;
#pragma unroll
        for (int a = 0; a < 2; ++a)
#pragma unroll
            for (int b = 0; b < 2; ++b)
#pragma unroll
                for (int m = 0; m < 4; ++m)
#pragma unroll
                    for (int n = 0; n < 2; ++n) acc[a][b][m][n] = (f32x4){0.f, 0.f, 0.f, 0.f};
        cur = nxt; cA = nA; cB = nB; ++ui;
    }
    PG8_WAIT_V(0);
    if (wr == 0) PG8_BAR;
    PG8_BAR;
    if constexpr (Epi::AFTER_DRAIN) { E.fused(acc, cur, wr, wc, fr, fq, lds, wid, lane); S.done(cur); }
#undef PG8_SA
#undef PG8_SB
#undef PG8_STAGE
#undef PG8_LDA
#undef PG8_LDB
#undef PG8_MMA
#undef PG8_WAIT_V
#undef PG8_WAIT_L
#undef PG8_BAR
#undef PG8_SCHED
}
}

__device__ __forceinline__ void transpose_item(const float* __restrict__ W, int src_ld, int src_col, bf16_t* __restrict__ WT, int K, int dst_row, int k0, LAS float* scr, int lane) {
    const int kr = lane >> 4, n4 = (lane & 15) * 4;
    f32x4 v[16];
#pragma unroll
    for (int i = 0; i < 16; ++i) v[i] = __builtin_nontemporal_load((const f32x4*)(W + (size_t)(k0 + i * 4 + kr) * src_ld + src_col + n4));
#pragma unroll
    for (int i = 0; i < 16; ++i) { LAS float* s = scr + (i * 4 + kr) * 65 + n4; s[0] = v[i][0]; s[1] = v[i][1]; s[2] = v[i][2]; s[3] = v[i][3]; }
    LDS_WAIT();
    const int c = lane & 7, nn = lane >> 3;
#pragma unroll
    for (int j = 0; j < 8; ++j) { const int n = nn + 8 * j; const LAS float* s = scr + (8 * c) * 65 + n;
        u32x4 o; o.x = pk2(s[0 * 65], s[1 * 65]); o.y = pk2(s[2 * 65], s[3 * 65]); o.z = pk2(s[4 * 65], s[5 * 65]); o.w = pk2(s[6 * 65], s[7 * 65]);
        *(u32x4*)(WT + (size_t)(dst_row + n) * K + k0 + 8 * c) = o; }
    LDS_WAIT();
}
__device__ __forceinline__ float log_sigmoid_(float x) { return fminf(x, 0.f) - log1pf(expf(-fabsf(x))); }

__device__ __forceinline__ void phase_prep(const Params& p, LAS unsigned char* lds) {
    const int tid = threadIdx.x, lane = tid & 63, wave = tid >> 6;
    LAS float* wg = (LAS float*)lds;
    LAS float* scr = (LAS float*)(lds + wave * 16640);
    bf16_t* WIN = (bf16_t*)(p.ws + WS_WIN); bf16_t* WA = (bf16_t*)(p.ws + WS_WA); bf16_t* WB = (bf16_t*)(p.ws + WS_WB);
    bf16_t* WOUT = (bf16_t*)(p.ws + WS_WOUT); bf16_t* WUP = (bf16_t*)(p.ws + WS_WUP); bf16_t* WDN = (bf16_t*)(p.ws + WS_WDN);
    const int gw = blockIdx.x * 8 + wave, NGW = gridDim.x * 8;
    constexpr int I_IN = 32 * 256, I_SQ = 32 * 32, I_UP = 32 * 128, I_DN = 128 * 32, NITEMS = I_IN + 3 * I_SQ + I_UP + I_DN;
    for (int it = gw; it < NITEMS; it += NGW) {
        int r = it;
        if (r < I_IN) { const int kb = r >> 8, nb = r & 255, n0 = nb * 64; transpose_item(p.w_in, DIN, n0 + (n0 >= 4096 ? 8 : 0), WIN, D, n0, kb * 64, scr, lane); continue; } r -= I_IN;
        if (r < I_SQ) { const int kb = r >> 5, nb = r & 31; transpose_item(p.w_a, D, nb * 64, WA, D, nb * 64, kb * 64, scr, lane); continue; } r -= I_SQ;
        if (r < I_SQ) { const int kb = r >> 5, nb = r & 31; transpose_item(p.w_b, D, nb * 64, WB, D, nb * 64, kb * 64, scr, lane); continue; } r -= I_SQ;
        if (r < I_SQ) { const int kb = r >> 5, nb = r & 31; transpose_item(p.w_out, D, nb * 64, WOUT, D, nb * 64, kb * 64, scr, lane); continue; } r -= I_SQ;
        if (r < I_UP) { const int kb = r >> 7, nb = r & 127; transpose_item(p.w_up, DFF, nb * 64, WUP, D, nb * 64, kb * 64, scr, lane); continue; } r -= I_UP;
        { const int kb = r >> 5, nb = r & 31; transpose_item(p.w_dn, D, nb * 64, WDN, DFF, nb * 64, kb * 64, scr, lane); }
    }
    __syncthreads();
    for (int d = tid; d < D; d += 512) {
        const f32x4 a = *(const f32x4*)(p.w_in + (size_t)d * DIN + 4096), b = *(const f32x4*)(p.w_in + (size_t)d * DIN + 4100);
#pragma unroll
        for (int q = 0; q < 4; ++q) { wg[q * 2048 + d] = a[q]; wg[(4 + q) * 2048 + d] = b[q]; }
    }
    __syncthreads();
    bf16_t* XB = (bf16_t*)(p.ws + WS_XB); float* GATES = (float*)(p.ws + WS_GATES);
    for (int row = gw; row < NT; row += NGW) {
        const float* xr = row < NTP ? p.xp + (size_t)row * D : p.xs + (size_t)(row - NTP) * D;
        float gs[8];
#pragma unroll
        for (int e = 0; e < 8; ++e) gs[e] = 0.f;
#pragma unroll
        for (int j = 0; j < 8; ++j) {
            const f32x4 v = ((const f32x4*)xr)[lane + 64 * j];
            u32x2 o; o.x = pk2(v[0], v[1]); o.y = pk2(v[2], v[3]);
            ((u32x2*)(XB + (size_t)row * D))[lane + 64 * j] = o;
#pragma unroll
            for (int q = 0; q < 8; ++q) { const f32x4 wv = *(const LAS f32x4*)(wg + q * 2048 + 4 * (lane + 64 * j));
                gs[q] += (v[0] * wv[0] + v[1] * wv[1]) + (v[2] * wv[2] + v[3] * wv[3]); }
        }
#pragma unroll
        for (int e = 0; e < 8; ++e) gs[e] = wave_sum(gs[e]);
        if (lane < 4) { float gi = lane == 0 ? gs[0] : lane == 1 ? gs[1] : lane == 2 ? gs[2] : gs[3];
            float gf = lane == 0 ? gs[4] : lane == 1 ? gs[5] : lane == 2 ? gs[6] : gs[7];
            GATES[(size_t)row * 8 + lane] = gi + p.b_ig[lane];
            GATES[(size_t)row * 8 + 4 + lane] = log_sigmoid_(gf + p.b_fg[lane]); }
    }
}

__device__ __forceinline__ void gate_scan(const Params& p) {
    const int lane = threadIdx.x & 63, gw = blockIdx.x * 8 + (threadIdx.x >> 6);
    if (gw >= (NTP / 64) * 4) return;
    const int chunk = gw >> 2, h = gw & 3; const size_t tok = (size_t)chunk * 64 + lane;
    const float* GATES = (const float*)(p.ws + WS_GATES);
    const float ig = GATES[tok * 8 + h], lf = GATES[tok * 8 + 4 + h];
    float bt = lf;
#pragma unroll
    for (int o = 1; o < 64; o <<= 1) { const float y = __shfl_up(bt, o); if (lane >= o) bt += y; }
    const float a_t = ig - bt;
    float cm = a_t;
#pragma unroll
    for (int o = 1; o < 64; o <<= 1) { const float y = __shfl_up(cm, o); if (lane >= o) cm = fmaxf(cm, y); }
    *(f32x4*)((float*)(p.ws + WS_GSCAN) + (tok * 4 + h) * 4) = (f32x4){bt, a_t, cm, 0.f};
}

template <bool IS_ML>
__device__ __forceinline__ void chain_item(const Params& p, LAS unsigned char* lds, int bh, int sl) {
    constexpr int DK = IS_ML ? 256 : 128, NPC = DK / 64, NRB = DK / 16;
    constexpr int QS = (DK + 8) * 2, TS = 144, VRS = 272;
    constexpr int OFF_Q = 0, OFF_K = OFF_Q + 64 * QS, OFF_KT = OFF_K + 64 * QS, OFF_VT = OFF_KT + DK * TS, OFF_VR = OFF_VT + 128 * TS, OFF_P = OFF_VR + 64 * VRS, OFF_SM = OFF_P + 64 * TS;
    static_assert(OFF_SM + 10240 + 16 <= LDS_BYTES, "chain LDS");
    const int tid = threadIdx.x, lane = tid & 63, w = tid >> 6, g = lane >> 4, c16 = lane & 15;
    const int b = IS_ML ? (bh >> 2) : (bh >> 3), h = IS_ML ? (bh & 3) : (bh & 7);
    const bool isden = IS_ML && sl == 4;
    const int qcol = IS_ML ? C_MLQ + h * 256 : C_HGQ + h * 128, kcol = IS_ML ? C_MLK + h * 256 : C_HGF + h * 128;
    const int vcol = IS_ML ? C_MLV + h * 512 + (isden ? 0 : sl) * 128 : C_HGI + h * 256 + sl * 128;
    const bf16_t* proj = (const bf16_t*)(p.ws + WS_PROJ);
    const float* GSCAN = (const float*)(p.ws + WS_GSCAN);
    const size_t tok0 = (size_t)b * 2048;
    LAS unsigned char* Q = lds + OFF_Q; LAS unsigned char* Kr = lds + OFF_K; LAS unsigned char* KT = lds + OFF_KT;
    LAS unsigned char* VT = lds + OFF_VT; LAS unsigned char* VR = lds + OFF_VR; LAS unsigned char* P = lds + OFF_P;
    LAS float* SM = (LAS float*)(lds + OFF_SM);
    LAS float* SMW = SM + w * 320;
    const int prow = tid >> 3, pseg = tid & 7;
    u32x4 pq[NPC], pk[NPC], pv[2]; f32x4 pgs = (f32x4){0.f, 0.f, 0.f, 0.f};
    auto prefetch = [&](int c) {
        const bf16_t* rp = proj + (tok0 + c * 64 + prow) * NP;
#pragma unroll
        for (int i = 0; i < NPC; ++i) { pq[i] = *(const u32x4*)(rp + qcol + i * 64 + pseg * 8); pk[i] = *(const u32x4*)(rp + kcol + i * 64 + pseg * 8); }
        if (!isden) {
#pragma unroll
            for (int i = 0; i < 2; ++i) pv[i] = *(const u32x4*)(rp + vcol + i * 64 + pseg * 8); }
        if (IS_ML) pgs = *(const f32x4*)(GSCAN + ((tok0 + c * 64 + lane) * 4 + h) * 4);
    };
    prefetch(0);
    f32x4 S[NRB];
#pragma unroll
    for (int i = 0; i < NRB; ++i) S[i] = (f32x4){0.f, 0.f, 0.f, 0.f};
    float m_prev = 0.f;
    float lbk = 0.f;
    if (!IS_ML) { const int k = tid & 127; lbk = sigmoidf_(p.lbl[h * 128 + k] - p.lbl[1024 + h * 128 + k]); }
    bf16_t* OUT = (bf16_t*)(p.ws + (IS_ML ? WS_HA : WS_OB));
    const int ocol = IS_ML ? h * 512 + sl * 128 + w * 16 + c16 : h * 256 + sl * 128 + w * 16 + c16;

    for (int c = 0; c < 32; ++c) {
#pragma unroll
        for (int i = 0; i < NPC; ++i) { *(LAS u32x4*)(Q + prow * QS + (i * 64 + pseg * 8) * 2) = pq[i]; *(LAS u32x4*)(Kr + prow * QS + (i * 64 + pseg * 8) * 2) = pk[i]; }
        if (!isden) {
#pragma unroll
            for (int i = 0; i < 2; ++i) *(LAS u32x4*)(VR + prow * VRS + (i * 64 + pseg * 8) * 2) = pv[i]; }
        const f32x4 gs = pgs;
        if (c + 1 < 32) prefetch(c + 1);
        LDS_BAR();
        float a_t = 0.f, M_t = 0.f, wint = 1.f, mt = 0.f, decay = 1.f, m_new = 0.f;
        if (IS_ML) {
            const float bt = gs[0];
            a_t = gs[1];
            M_t = fmaxf(m_prev, gs[2]);
            const float M_end = __shfl(M_t, 63), b_end = __shfl(bt, 63);
            wint = __expf(m_prev - M_t); mt = bt + M_t;
            const float wend = __expf(a_t - M_end);
            decay = __expf(m_prev - M_end); m_new = b_end + M_end;
            SMW[lane] = a_t; SMW[64 + lane] = M_t; SMW[128 + lane] = wint; SMW[192 + lane] = mt; SMW[256 + lane] = wend;
            LDS_WAIT();
            { const int sp = tid & 31, seg = tid >> 5;
                const f32x2 wv = *(const LAS f32x2*)(SMW + 256 + 2 * sp); const float w0 = wv[0] * 0.0625f, w1 = wv[1] * 0.0625f;
                const u32x4 r0a = *(const LAS u32x4*)(Kr + (2 * sp) * QS + seg * 32), r0b = *(const LAS u32x4*)(Kr + (2 * sp) * QS + seg * 32 + 16);
                const u32x4 r1a = *(const LAS u32x4*)(Kr + (2 * sp + 1) * QS + seg * 32), r1b = *(const LAS u32x4*)(Kr + (2 * sp + 1) * QS + seg * 32 + 16);
                const unsigned x0[8] = {r0a.x, r0a.y, r0a.z, r0a.w, r0b.x, r0b.y, r0b.z, r0b.w};
                const unsigned x1[8] = {r1a.x, r1a.y, r1a.z, r1a.w, r1b.x, r1b.y, r1b.z, r1b.w};
#pragma unroll
                for (int e = 0; e < 8; ++e) {
                    *(LAS unsigned*)(KT + (seg * 16 + 2 * e) * TS + sp * 4) = pk2(bflo(x0[e]) * w0, bflo(x1[e]) * w1);
                    *(LAS unsigned*)(KT + (seg * 16 + 2 * e + 1) * TS + sp * 4) = pk2(bfhi(x0[e]) * w0, bfhi(x1[e]) * w1); }
            }
        } else {
            const int k = tid & 127, tq = tid >> 7;
            float G[16], kc[16], qv[16];
            float run = 0.f;
#pragma unroll
            for (int i = 0; i < 16; ++i) { const int t = tq * 16 + i;
                const float x = bf1(*(const LAS unsigned short*)(Kr + t * QS + k * 2));
                qv[i] = bf1(*(const LAS unsigned short*)(Q + t * QS + k * 2));
                const float sp_ = __builtin_amdgcn_rcpf(1.f + __expf(-x)), sm_ = __builtin_amdgcn_rcpf(1.f + __expf(x));
                const float f = lbk + (1.f - lbk) * sp_;
                kc[i] = (1.f - lbk) * sm_;
                run += __logf(f); G[i] = run; }
            SM[tq * 128 + k] = run;
            LDS_BAR();
            const float t0 = SM[k], t1 = SM[128 + k], t2 = SM[256 + k], t3 = SM[384 + k];
            const float pre = (tq > 0 ? t0 : 0.f) + (tq > 1 ? t1 : 0.f) + (tq > 2 ? t2 : 0.f);
            const float Gend = (t0 + t1) + (t2 + t3);
            if (tq == 0) SM[512 + k] = __expf(Gend);
            unsigned kt[8];
#pragma unroll
            for (int i = 0; i < 16; i += 2) {
                const float d0 = Gend - (pre + G[i]), d1 = Gend - (pre + G[i + 1]);
                const float kg0 = kc[i] * __expf(d0), kg1 = kc[i + 1] * __expf(d1);
                const float qg0 = qv[i] * __expf(-d0), qg1 = qv[i + 1] * __expf(-d1);
                const unsigned kp = pk2(kg0, kg1), qp = pk2(qg0, qg1);
                kt[i >> 1] = kp;
                *(LAS unsigned short*)(Kr + (tq * 16 + i) * QS + k * 2) = (unsigned short)(kp & 0xffffu);
                *(LAS unsigned short*)(Kr + (tq * 16 + i + 1) * QS + k * 2) = (unsigned short)(kp >> 16);
                *(LAS unsigned short*)(Q + (tq * 16 + i) * QS + k * 2) = (unsigned short)(qp & 0xffffu);
                *(LAS unsigned short*)(Q + (tq * 16 + i + 1) * QS + k * 2) = (unsigned short)(qp >> 16); }
            *(LAS u32x4*)(KT + k * TS + tq * 32) = (u32x4){kt[0], kt[1], kt[2], kt[3]};
            *(LAS u32x4*)(KT + k * TS + tq * 32 + 16) = (u32x4){kt[4], kt[5], kt[6], kt[7]};
        }
        if (!isden && tid < 256) { const int sp = tid & 31, seg = tid >> 5;
            const u32x4 r0a = *(const LAS u32x4*)(VR + (2 * sp) * VRS + seg * 32), r0b = *(const LAS u32x4*)(VR + (2 * sp) * VRS + seg * 32 + 16);
            const u32x4 r1a = *(const LAS u32x4*)(VR + (2 * sp + 1) * VRS + seg * 32), r1b = *(const LAS u32x4*)(VR + (2 * sp + 1) * VRS + seg * 32 + 16);
            const unsigned x0[8] = {r0a.x, r0a.y, r0a.z, r0a.w, r0b.x, r0b.y, r0b.z, r0b.w};
            const unsigned x1[8] = {r1a.x, r1a.y, r1a.z, r1a.w, r1b.x, r1b.y, r1b.z, r1b.w};
#pragma unroll
            for (int e = 0; e < 8; ++e) {
                *(LAS unsigned*)(VT + (seg * 16 + 2 * e) * TS + sp * 4) = (x0[e] & 0xffffu) | (x1[e] << 16);
                *(LAS unsigned*)(VT + (seg * 16 + 2 * e + 1) * TS + sp * 4) = (x0[e] >> 16) | (x1[e] & 0xffff0000u); }
        }
        if (!IS_ML) LDS_BAR();
        { const int tr = w >> 1, tc0 = (w & 1) * 2;
            f32x4 pacc[2] = {(f32x4){0.f, 0.f, 0.f, 0.f}, (f32x4){0.f, 0.f, 0.f, 0.f}};
            if (tc0 <= tr) {
                const bool two = (tc0 + 1 <= tr);
#pragma unroll
                for (int kk = 0; kk < DK / 32; ++kk) {
                    const bf16x8 A = *(const LAS bf16x8*)(Q + (tr * 16 + c16) * QS + (kk * 32 + g * 8) * 2);
                    const bf16x8 B0 = *(const LAS bf16x8*)(Kr + (tc0 * 16 + c16) * QS + (kk * 32 + g * 8) * 2);
                    pacc[0] = __builtin_amdgcn_mfma_f32_16x16x32_bf16(A, B0, pacc[0], 0, 0, 0);
                    if (two) { const bf16x8 B1 = *(const LAS bf16x8*)(Kr + ((tc0 + 1) * 16 + c16) * QS + (kk * 32 + g * 8) * 2);
                        pacc[1] = __builtin_amdgcn_mfma_f32_16x16x32_bf16(A, B1, pacc[1], 0, 0, 0); } }
            }
#pragma unroll
            for (int ti = 0; ti < 2; ++ti) { const int tc = tc0 + ti;
                const f32x4 acc = pacc[ti];
                const int s = tc * 16 + c16;
                float as_ = 0.f; f32x4 Mv = (f32x4){0.f, 0.f, 0.f, 0.f};
                if (IS_ML) { as_ = SMW[s]; Mv = *(const LAS f32x4*)(SMW + 64 + tr * 16 + g * 4); }
#pragma unroll
                for (int j = 0; j < 4; ++j) { const int t = tr * 16 + g * 4 + j;
                    float v = acc[j];
                    if (IS_ML) { v = v * 0.0625f * __expf(fminf(as_ - Mv[j], 0.f)); }
                    v = (s <= t) ? v : 0.f;
                    *(LAS unsigned short*)(P + t * TS + s * 2) = (unsigned short)(pk2(v, 0.f) & 0xffffu); }
            }
        }
        LDS_BAR();
        if (!isden || w == 0) {
            bf16x8 Bv[2];
            if (isden) { const short one = (c16 == 0) ? (short)0x3F80 : (short)0;
                Bv[0] = (bf16x8){one, one, one, one, one, one, one, one}; Bv[1] = Bv[0]; }
            else {
#pragma unroll
                for (int ks = 0; ks < 2; ++ks) Bv[ks] = *(const LAS bf16x8*)(VT + (w * 16 + c16) * TS + (ks * 32 + g * 8) * 2); }
            if (!IS_ML) {
#pragma unroll
                for (int rb = 0; rb < NRB; ++rb) { const f32x4 dv = *(const LAS f32x4*)(SM + 512 + rb * 16 + g * 4); S[rb] = S[rb] * dv; } }
            f32x4 o2[4];
#pragma unroll
            for (int tt = 0; tt < 4; ++tt) o2[tt] = (f32x4){0.f, 0.f, 0.f, 0.f};
#pragma unroll
            for (int i = 0; i < NRB / 2; ++i) {
                const unsigned b0 = pk2(S[2 * i][0], S[2 * i][1]), b1 = pk2(S[2 * i][2], S[2 * i][3]), b2 = pk2(S[2 * i + 1][0], S[2 * i + 1][1]), b3 = pk2(S[2 * i + 1][2], S[2 * i + 1][3]);
                const u32x4 bu = (u32x4){b0, b1, b2, b3};
                const bf16x8 Bs = __builtin_bit_cast(bf16x8, bu);
#pragma unroll
                for (int tt = 0; tt < 4; ++tt) {
                    const u32x2 a0 = *(const LAS u32x2*)(Q + (tt * 16 + c16) * QS + ((2 * i) * 16 + g * 4) * 2);
                    const u32x2 a1 = *(const LAS u32x2*)(Q + (tt * 16 + c16) * QS + ((2 * i + 1) * 16 + g * 4) * 2);
                    const u32x4 au = (u32x4){a0.x, a0.y, a1.x, a1.y};
                    o2[tt] = __builtin_amdgcn_mfma_f32_16x16x32_bf16(__builtin_bit_cast(bf16x8, au), Bs, o2[tt], 0, 0, 0); }
                if ((i & 1) == 1) __builtin_amdgcn_sched_barrier(0);
            }
            if (IS_ML) {
#pragma unroll
                for (int tt = 0; tt < 4; ++tt) o2[tt] = o2[tt] * *(const LAS f32x4*)(SMW + 128 + tt * 16 + g * 4); }
#pragma unroll
            for (int tt = 0; tt < 4; ++tt) {
#pragma unroll
                for (int ks = 0; ks < 2; ++ks) { const bf16x8 A = *(const LAS bf16x8*)(P + (tt * 16 + c16) * TS + (ks * 32 + g * 8) * 2);
                    o2[tt] = __builtin_amdgcn_mfma_f32_16x16x32_bf16(A, Bv[ks], o2[tt], 0, 0, 0); } }
#pragma unroll
            for (int tt = 0; tt < 4; ++tt)
#pragma unroll
                for (int j = 0; j < 4; ++j) { const int t = tt * 16 + g * 4 + j;
                    const float v = o2[tt][j];
                    const size_t tok = tok0 + c * 64 + t;
                    if (isden) { const float mtt = SMW[192 + t];
                        if (c16 == 0) { ((float*)(p.ws + WS_DEN))[tok * 4 + h] = v; ((float*)(p.ws + WS_MT))[tok * 4 + h] = mtt; } }
                    else OUT[tok * D + ocol] = (bf16_t)(pk2(v, 0.f) & 0xffffu); }
            __builtin_amdgcn_sched_barrier(0);
#pragma unroll
            for (int rb = 0; rb < NRB; ++rb) {
                f32x4 acc = IS_ML ? S[rb] * decay : S[rb];
#pragma unroll
                for (int ks = 0; ks < 2; ++ks) { const bf16x8 A = *(const LAS bf16x8*)(KT + (rb * 16 + c16) * TS + (ks * 32 + g * 8) * 2);
                    acc = __builtin_amdgcn_mfma_f32_16x16x32_bf16(A, Bv[ks], acc, 0, 0, 0); }
                S[rb] = acc;
                if ((rb & 3) == 3) __builtin_amdgcn_sched_barrier(0); }
        }
        m_prev = m_new;
        LDS_BAR();
    }
    if (IS_ML) {
        if (!isden) { float* Co = p.out + O_CP + (size_t)bh * 256 * 512 + sl * 128 + w * 16 + c16;
#pragma unroll
            for (int rb = 0; rb < NRB; ++rb)
#pragma unroll
                for (int j = 0; j < 4; ++j) Co[(size_t)(rb * 16 + g * 4 + j) * 512] = S[rb][j]; }
        else if (w == 0) {
            if (c16 == 0) {
#pragma unroll
                for (int rb = 0; rb < NRB; ++rb)
#pragma unroll
                    for (int j = 0; j < 4; ++j) p.out[O_NP + (size_t)bh * 256 + rb * 16 + g * 4 + j] = S[rb][j]; }
            if (lane == 0) p.out[O_MP + bh] = m_prev; }
    } else {
        float* So = p.out + O_SP + (size_t)bh * 128 * 256 + sl * 128 + w * 16 + c16;
#pragma unroll
        for (int rb = 0; rb < NRB; ++rb)
#pragma unroll
            for (int j = 0; j < 4; ++j) So[(size_t)(rb * 16 + g * 4 + j) * 256] = S[rb][j];
    }
}

template <bool IS_ML>
__device__ __forceinline__ void stream_item(const Params& p, LAS unsigned char* lds, int bh) {
    constexpr int K = IS_ML ? 256 : 128, V = IS_ML ? 512 : 256, NH = IS_ML ? 4 : 8;
    constexpr int CG = V / 4, RG = 512 / CG, NR = K / RG, U = 8;
    constexpr int OFF_A = 0, OFF_B = OFF_A + K * 64, OFF_DEC = OFF_B + K * 64, OFF_VV = OFF_DEC + K * 4, OFF_PP = OFF_VV + 8 * V * 4, OFF_PART = OFF_PP + 256, OFF_QN = OFF_PART + 2048, OFF_RED = OFF_QN + 256;
    static_assert(OFF_RED + RG * 8 * V * 4 <= LDS_BYTES, "stream LDS");
    LAS float* A16 = (LAS float*)(lds + OFF_A); LAS float* B16 = (LAS float*)(lds + OFF_B); LAS float* DEC = (LAS float*)(lds + OFF_DEC);
    LAS float* VV = (LAS float*)(lds + OFF_VV); LAS float* PP = (LAS float*)(lds + OFF_PP); LAS float* PART = (LAS float*)(lds + OFF_PART);
    LAS float* QN = (LAS float*)(lds + OFF_QN); LAS float* RED = (LAS float*)(lds + OFF_RED);
    const int tid = threadIdx.x, lane = tid & 63, w = tid >> 6;
    const int b = bh / NH, h = bh % NH;
    const size_t tok0 = (size_t)NTP + (size_t)b * 8;
    const bf16_t* proj = (const bf16_t*)(p.ws + WS_PROJ);
    float wint[8], a_[8], M_[8], mt[8]; float decay = 1.f, m_new = 0.f;
#pragma unroll
    for (int t = 0; t < 8; ++t) { wint[t] = 1.f; a_[t] = 0.f; M_[t] = 0.f; mt[t] = 0.f; }
    if (IS_ML) {
        const float* GATES = (const float*)(p.ws + WS_GATES);
        const float m0 = p.m0[bh];
        float bt = 0.f, cm = -3.0e38f, wend[8];
#pragma unroll
        for (int t = 0; t < 8; ++t) { const float ig = GATES[(tok0 + t) * 8 + h], lf = GATES[(tok0 + t) * 8 + 4 + h];
            bt += lf; a_[t] = ig - bt; cm = fmaxf(cm, a_[t]); M_[t] = fmaxf(m0, cm); mt[t] = bt + M_[t]; wint[t] = __expf(m0 - M_[t]); }
        const float M_end = M_[7];
        decay = __expf(m0 - M_end); m_new = bt + M_end;
#pragma unroll
        for (int t = 0; t < 8; ++t) wend[t] = __expf(a_[t] - M_end);
        { const int t = tid >> 6, k4 = (tid & 63) * 4;
            const u32x2 qv = *(const u32x2*)(proj + (tok0 + t) * NP + C_MLQ + h * 256 + k4), kv = *(const u32x2*)(proj + (tok0 + t) * NP + C_MLK + h * 256 + k4);
            const float qf[4] = {bflo(qv.x), bfhi(qv.x), bflo(qv.y), bfhi(qv.y)};
            const float kf[4] = {bflo(kv.x) * 0.0625f, bfhi(kv.x) * 0.0625f, bflo(kv.y) * 0.0625f, bfhi(kv.y) * 0.0625f};
            float we = wend[0];
#pragma unroll
            for (int u = 1; u < 8; ++u) we = (t == u) ? wend[u] : we;
#pragma unroll
            for (int e = 0; e < 4; ++e) { A16[(k4 + e) * 16 + t] = qf[e]; A16[(k4 + e) * 16 + 8 + t] = kf[e] * we; B16[(k4 + e) * 16 + t] = qf[e]; B16[(k4 + e) * 16 + 8 + t] = kf[e]; } }
        { const int t = tid >> 6, c8 = (tid & 63) * 8;
            const u32x4 vv = *(const u32x4*)(proj + (tok0 + t) * NP + C_MLV + h * 512 + c8);
            *(LAS f32x4*)(VV + t * V + c8) = (f32x4){bflo(vv.x), bfhi(vv.x), bflo(vv.y), bfhi(vv.y)};
            *(LAS f32x4*)(VV + t * V + c8 + 4) = (f32x4){bflo(vv.z), bfhi(vv.z), bflo(vv.w), bfhi(vv.w)}; }
    } else {
        if (tid < 128) { const int k = tid;
            const float lbk = sigmoidf_(p.lbl[h * 128 + k] - p.lbl[1024 + h * 128 + k]);
            float G[8], kc[8], qv[8]; float run = 0.f;
#pragma unroll
            for (int t = 0; t < 8; ++t) { const float x = bf1(proj[(tok0 + t) * NP + C_HGF + h * 128 + k]); qv[t] = bf1(proj[(tok0 + t) * NP + C_HGQ + h * 128 + k]);
                const float sp_ = __builtin_amdgcn_rcpf(1.f + __expf(-x)), sm_ = __builtin_amdgcn_rcpf(1.f + __expf(x));
                const float f = lbk + (1.f - lbk) * sp_; kc[t] = (1.f - lbk) * sm_; run += __logf(f); G[t] = run; }
            const float dec = __expf(run);
            DEC[k] = dec;
#pragma unroll
            for (int t = 0; t < 8; ++t) { const float e = __expf(run - G[t]), kw = kc[t] * e, qg = qv[t] * __expf(G[t] - run);
                A16[k * 16 + t] = qg * dec; A16[k * 16 + 8 + t] = kw; B16[k * 16 + t] = qg; B16[k * 16 + 8 + t] = kw; } }
        { const int t = tid >> 6, c4 = (tid & 63) * 4;
            const u32x2 vv = *(const u32x2*)(proj + (tok0 + t) * NP + C_HGI + h * 256 + c4);
            *(LAS f32x4*)(VV + t * V + c4) = (f32x4){bflo(vv.x), bfhi(vv.x), bflo(vv.y), bfhi(vv.y)}; }
    }
    __syncthreads();
    { const int pair = tid & 63, t = pair >> 3, s = pair & 7, part = tid >> 6; float acc = 0.f;
#pragma unroll 8
        for (int k = part * (K / 8); k < (part + 1) * (K / 8); ++k) acc += B16[k * 16 + t] * B16[k * 16 + 8 + s];
        PART[part * 64 + pair] = acc; }
    if (IS_ML && tid < 256) { const int dk = tid; const float n0v = p.n0[(size_t)bh * 256 + dk];
        float nn = decay * n0v;
#pragma unroll
        for (int s = 0; s < 8; ++s) nn += A16[dk * 16 + 8 + s];
        p.out[O_NS + (size_t)bh * 256 + dk] = nn;
#pragma unroll
        for (int t = 0; t < 8; ++t) { const float pr = wave_sum(A16[dk * 16 + t] * n0v); if (lane == 0) QN[w * 8 + t] = pr; } }
    __syncthreads();
    if (tid < 64) { const int t = tid >> 3, s = tid & 7; float v = 0.f;
#pragma unroll
        for (int q = 0; q < 8; ++q) v += PART[q * 64 + tid];
        if (IS_ML) { float as_ = a_[0], Mt = M_[0];
#pragma unroll
            for (int u = 1; u < 8; ++u) { as_ = (s == u) ? a_[u] : as_; Mt = (t == u) ? M_[u] : Mt; }
            v *= __expf(fminf(as_ - Mt, 0.f)); }
        PP[tid] = (s <= t) ? v : 0.f; }
    __syncthreads();
    if (IS_ML && tid < 8) { const int t = tid; float den = 0.f;
#pragma unroll
        for (int s = 0; s < 8; ++s) den += PP[t * 8 + s];
        float wi = wint[0], mtt = mt[0];
#pragma unroll
        for (int u = 1; u < 8; ++u) { wi = (t == u) ? wint[u] : wi; mtt = (t == u) ? mt[u] : mtt; }
        den += wi * ((QN[t] + QN[8 + t]) + (QN[16 + t] + QN[24 + t]));
        ((float*)(p.ws + WS_DEN))[(tok0 + t) * 4 + h] = den; ((float*)(p.ws + WS_MT))[(tok0 + t) * 4 + h] = mtt;
        if (t == 0) p.out[O_MS + bh] = m_new; }
    { const int cgid = tid % CG, rg = tid / CG, col = cgid * 4;
        const float* __restrict__ src = (IS_ML ? p.C0 : p.S0) + (size_t)bh * K * V + col;
        float* __restrict__ dst = p.out + (IS_ML ? O_CS : O_SS) + (size_t)bh * K * V + col;
        f32x4 acc[8], vv[8];
#pragma unroll
        for (int t = 0; t < 8; ++t) { acc[t] = (f32x4){0.f, 0.f, 0.f, 0.f}; vv[t] = *(const LAS f32x4*)(VV + t * V + col); }
        for (int r0 = 0; r0 < NR; r0 += U) {
            f32x4 cv[U];
#pragma unroll
            for (int u = 0; u < U; ++u) cv[u] = __builtin_nontemporal_load((const f32x4*)(src + (size_t)(rg + RG * (r0 + u)) * V));
#pragma unroll
            for (int u = 0; u < U; ++u) { const int k = rg + RG * (r0 + u);
                const f32x4 q0 = *(const LAS f32x4*)(A16 + k * 16), q1 = *(const LAS f32x4*)(A16 + k * 16 + 4), k0 = *(const LAS f32x4*)(A16 + k * 16 + 8), k1 = *(const LAS f32x4*)(A16 + k * 16 + 12);
                const float dec = IS_ML ? decay : DEC[k];
                f32x4 cn = cv[u] * dec;
#pragma unroll
                for (int t = 0; t < 4; ++t) { acc[t] += cv[u] * q0[t]; acc[4 + t] += cv[u] * q1[t]; cn += vv[t] * k0[t]; cn += vv[4 + t] * k1[t]; }
                __builtin_nontemporal_store(cn, (f32x4*)(dst + (size_t)k * V));
                __builtin_amdgcn_sched_barrier(0); }
        }
#pragma unroll
        for (int t = 0; t < 8; ++t) *(LAS f32x4*)(RED + (rg * 8 + t) * V + col) = acc[t];
    }
    __syncthreads();
    { bf16_t* OUT = (bf16_t*)(p.ws + (IS_ML ? WS_HA : WS_OB));
        for (int idx = tid; idx < 8 * CG; idx += 512) { const int t = idx / CG, col = (idx % CG) * 4;
            f32x4 sacc = (f32x4){0.f, 0.f, 0.f, 0.f};
#pragma unroll
            for (int r = 0; r < RG; ++r) sacc += *(const LAS f32x4*)(RED + (r * 8 + t) * V + col);
            if (IS_ML) { float wi = wint[0];
#pragma unroll
                for (int u = 1; u < 8; ++u) wi = (t == u) ? wint[u] : wi;
                sacc *= wi; }
#pragma unroll
            for (int s = 0; s < 8; ++s) sacc += *(const LAS f32x4*)(VV + s * V + col) * PP[t * 8 + s];
            u32x2 ob; ob.x = pk2(sacc[0], sacc[1]); ob.y = pk2(sacc[2], sacc[3]); *(u32x2*)(OUT + (tok0 + t) * D + h * V + col) = ob; } }
    __syncthreads();
}

constexpr int N_ML_CHAIN = 80, N_HG_CHAIN = 64, N_ML_STREAM = 512, N_HG_STREAM = 1024;
constexpr int N_REC_ITEMS = N_ML_CHAIN + N_HG_CHAIN + N_ML_STREAM + N_HG_STREAM;
#ifndef RECMASK
#define RECMASK 15
#endif
__device__ __forceinline__ int queue_next(unsigned* ctr, LAS int* slot) {
    if (threadIdx.x == 0) *slot = (int)atomicAdd(ctr, 1u);
    __syncthreads();
    const int it = *slot;
    __syncthreads();
    return it;
}
__device__ __forceinline__ void phase_rec(const Params& p, LAS unsigned char* lds, int cbase) {
    unsigned* ctr = (unsigned*)(p.ws + WS_CTL) + cbase;
    LAS int* slot = (LAS int*)(lds + LDS_BYTES - 16);
    if (RECMASK & 1) for (;;) { const int it = queue_next(ctr + 0, slot); if (it >= N_ML_CHAIN) break; chain_item<true>(p, lds, it / 5, it % 5); }
    if (RECMASK & 2) for (;;) { const int it = queue_next(ctr + 1, slot); if (it >= N_HG_CHAIN) break; chain_item<false>(p, lds, it >> 1, it & 1); }
    if (RECMASK & 4) for (;;) { const int it = queue_next(ctr + 2, slot); if (it >= N_ML_STREAM) break; stream_item<true>(p, lds, it); }
    if (RECMASK & 8) for (;;) { const int it = queue_next(ctr + 3, slot); if (it >= N_HG_STREAM) break; stream_item<false>(p, lds, it); }
}

__device__ __forceinline__ void phase_branch(const Params& p) {
    const int lane = threadIdx.x & 63, gw = blockIdx.x * 8 + (threadIdx.x >> 6), NGW = gridDim.x * 8;
    const bf16_t* proj = (const bf16_t*)(p.ws + WS_PROJ);
    const bf16_t* HA = (const bf16_t*)(p.ws + WS_HA); const bf16_t* OB = (const bf16_t*)(p.ws + WS_OB);
    const float* DEN = (const float*)(p.ws + WS_DEN); const float* MT = (const float*)(p.ws + WS_MT);
    bf16_t* BRA = (bf16_t*)(p.ws + WS_BRA); bf16_t* BRB = (bf16_t*)(p.ws + WS_BRB);
    for (int row = gw; row < NT; row += NGW) {
#pragma unroll
        for (int h = 0; h < 4; ++h) {
            const u32x4 hv = *(const u32x4*)(HA + (size_t)row * D + h * 512 + lane * 8);
            f32x4 v0 = (f32x4){bflo(hv.x), bfhi(hv.x), bflo(hv.y), bfhi(hv.y)}, v1 = (f32x4){bflo(hv.z), bfhi(hv.z), bflo(hv.w), bfhi(hv.w)};
            const float den = DEN[(size_t)row * 4 + h], mtt = MT[(size_t)row * 4 + h];
            const float inv = 1.f / fmaxf(fabsf(den), expf(-mtt));
            v0 *= inv; v1 *= inv;
            const float mu = wave_sum((v0[0] + v0[1]) + (v0[2] + v0[3]) + (v1[0] + v1[1]) + (v1[2] + v1[3])) * (1.f / 512.f);
            v0 -= mu; v1 -= mu;
            const float var = wave_sum((v0[0] * v0[0] + v0[1] * v0[1]) + (v0[2] * v0[2] + v0[3] * v0[3]) + (v1[0] * v1[0] + v1[1] * v1[1]) + (v1[2] * v1[2] + v1[3] * v1[3])) * (1.f / 512.f);
            const float rstd = 1.f / sqrtf(var + LN_EPS);
            const f32x4 g0 = *(const f32x4*)(p.mlg + h * 512 + lane * 8), g1 = *(const f32x4*)(p.mlg + h * 512 + lane * 8 + 4);
            const u32x4 ov = *(const u32x4*)(proj + (size_t)row * NP + C_MLO + h * 512 + lane * 8);
            const float og[8] = {bflo(ov.x), bfhi(ov.x), bflo(ov.y), bfhi(ov.y), bflo(ov.z), bfhi(ov.z), bflo(ov.w), bfhi(ov.w)};
            float r[8];
#pragma unroll
            for (int e = 0; e < 4; ++e) { r[e] = v0[e] * rstd * g0[e] * sigmoidf_(og[e]); r[4 + e] = v1[e] * rstd * g1[e] * sigmoidf_(og[4 + e]); }
            u32x4 o; o.x = pk2(r[0], r[1]); o.y = pk2(r[2], r[3]); o.z = pk2(r[4], r[5]); o.w = pk2(r[6], r[7]);
            *(u32x4*)(BRA + (size_t)row * D + h * 512 + lane * 8) = o;
        }
#pragma unroll
        for (int h = 0; h < 8; ++h) {
            const u32x2 ovv = *(const u32x2*)(OB + (size_t)row * D + h * 256 + lane * 4);
            const f32x4 v = (f32x4){bflo(ovv.x), bfhi(ovv.x), bflo(ovv.y), bfhi(ovv.y)};
            const float ms = wave_sum((v[0] * v[0] + v[1] * v[1]) + (v[2] * v[2] + v[3] * v[3])) * (1.f / 256.f);
            const float rstd = 1.f / sqrtf(ms + LN_EPS);
            const f32x4 g = *(const f32x4*)(p.hgg + h * 256 + lane * 4);
            const u32x2 gv = *(const u32x2*)(proj + (size_t)row * NP + C_HGG + h * 256 + lane * 4);
            const float gg[4] = {bflo(gv.x), bfhi(gv.x), bflo(gv.y), bfhi(gv.y)};
            float r[4];
#pragma unroll
            for (int e = 0; e < 4; ++e) r[e] = v[e] * rstd * g[e] * gg[e] * sigmoidf_(gg[e]);
            u32x2 o; o.x = pk2(r[0], r[1]); o.y = pk2(r[2], r[3]);
            *(u32x2*)(BRB + (size_t)row * D + h * 256 + lane * 4) = o;
        }
    }
}

template <bool FIRST>
__device__ __forceinline__ void phase_ln(const bf16_t* Z, const float* RTF, const bf16_t* RTH, const bf16_t* PT, const float* gam, const float* bet, float* OF, bf16_t* OBF) {
    const int lane = threadIdx.x & 63, gw = blockIdx.x * 8 + (threadIdx.x >> 6), NGW = gridDim.x * 8;
    for (int row = gw; row < NT; row += NGW) {
        f32x4 v[8]; float s = 0.f;
        if (row < NTP) { const u32x2* zr = (const u32x2*)(Z + (size_t)row * D);
#pragma unroll
            for (int j = 0; j < 8; ++j) { const u32x2 h = zr[lane + 64 * j]; v[j] = (f32x4){bflo(h.x), bfhi(h.x), bflo(h.y), bfhi(h.y)}; } }
        else {
            if (FIRST) { const f32x4* rr = (const f32x4*)(RTF + (size_t)(row - NTP) * D);
#pragma unroll
                for (int j = 0; j < 8; ++j) v[j] = rr[lane + 64 * j] * ALPHA; }
            else { const u32x2* rr = (const u32x2*)(RTH + (size_t)row * D);
#pragma unroll
                for (int j = 0; j < 8; ++j) { const u32x2 h = rr[lane + 64 * j]; v[j] = (f32x4){bflo(h.x), bfhi(h.x), bflo(h.y), bfhi(h.y)} * ALPHA; } }
#pragma unroll
            for (int sidx = 0; sidx < 8; ++sidx) { const u32x2* pr = (const u32x2*)(PT + ((size_t)sidx * NTS + (row - NTP)) * D);
#pragma unroll
                for (int j = 0; j < 8; ++j) { const u32x2 h = pr[lane + 64 * j]; v[j] += (f32x4){bflo(h.x), bfhi(h.x), bflo(h.y), bfhi(h.y)}; } } }
#pragma unroll
        for (int j = 0; j < 8; ++j) s += (v[j][0] + v[j][1]) + (v[j][2] + v[j][3]);
        const float mu = wave_sum(s) * (1.f / D); float s2 = 0.f;
#pragma unroll
        for (int j = 0; j < 8; ++j) { v[j] -= mu; s2 += (v[j][0] * v[j][0] + v[j][1] * v[j][1]) + (v[j][2] * v[j][2] + v[j][3] * v[j][3]); }
        const float rstd = 1.f / sqrtf(wave_sum(s2) * (1.f / D) + LN_EPS);
#pragma unroll
        for (int j = 0; j < 8; ++j) { const f32x4 g = ((const f32x4*)gam)[lane + 64 * j], bb = ((const f32x4*)bet)[lane + 64 * j];
            const f32x4 o = v[j] * rstd * g + bb;
            if (FIRST) { u32x2 ob; ob.x = pk2(o[0], o[1]); ob.y = pk2(o[2], o[3]); ((u32x2*)(OBF + (size_t)row * D))[lane + 64 * j] = ob; }
            else ((f32x4*)(OF + (size_t)row * D))[lane + 64 * j] = o; }
    }
}

constexpr int N_PHASES = 10;
#ifndef PHMASK
#define PHMASK 1023
#endif
#ifndef PROBE_DUP
#define PROBE_DUP -1
#endif
#define PH_BEGIN(k) if ((k) > p.ph_lo && (k) < p.ph_hi) xcd_barrier(xb); if ((PHMASK & (1 << (k))) && (k) >= p.ph_lo && (k) < p.ph_hi)
__global__ void __launch_bounds__(512, 2) mega(Params p) {
    extern __shared__ __attribute__((aligned(16))) unsigned char shm[];
    LAS unsigned char* lds = (LAS unsigned char*)shm;
    cg::grid_group grid = cg::this_grid();
    if (p.ph_lo < 0) grid.sync();
    volatile LAS unsigned* xst = (volatile LAS unsigned*)(lds + LDS_BYTES - 32);
    if (threadIdx.x == 0) { xst[0] = 0u; xst[1] = 0u; }
    __syncthreads();
    const XcdBarrier xb = xcd_barrier_post((unsigned*)(p.ws + WS_BAR), xst);
    PH_BEGIN(0) phase_prep(p, lds);
    PH_BEGIN(1) { gate_scan(p);
        pg8::StaticOrder S; S.init(NT, NP, D, gridDim.x, blockIdx.x); pg8::Gemm g{(const bf16_t*)(p.ws + WS_XB), (const bf16_t*)(p.ws + WS_WIN), NT, NP, D};
        pg8::EpiProj E{(bf16_t*)(p.ws + WS_PROJ), NP}; pg8::gemm_phase(lds, g, S, E); }
    PH_BEGIN(2) phase_rec(p, lds, 0);
    PH_BEGIN(3) phase_branch(p);
    PH_BEGIN(4) {
        pg8::TailOrder S; S.init(D, gridDim.x, blockIdx.x);
        { pg8::Gemm g{(const bf16_t*)(p.ws + WS_BRA), (const bf16_t*)(p.ws + WS_WA), NT, D, D};
            pg8::EpiMerge<0> E{(const bf16_t*)(p.ws + WS_PROJ), (bf16_t*)(p.ws + WS_TMP), (bf16_t*)(p.ws + WS_MRG), (bf16_t*)(p.ws + WS_PART)}; pg8::gemm_phase(lds, g, S, E); }
        __syncthreads();
        { pg8::Gemm g{(const bf16_t*)(p.ws + WS_BRB), (const bf16_t*)(p.ws + WS_WB), NT, D, D};
            pg8::EpiMerge<1> E{(const bf16_t*)(p.ws + WS_PROJ), (bf16_t*)(p.ws + WS_TMP), (bf16_t*)(p.ws + WS_MRG), (bf16_t*)(p.ws + WS_PART)}; pg8::gemm_phase(lds, g, S, E); }
        xcd_barrier(xb);
        { const u32x2* tz = (const u32x2*)(p.ws + WS_PART); u32x2* mo = (u32x2*)((bf16_t*)(p.ws + WS_MRG) + (size_t)NTP * D);
            for (int i = blockIdx.x * 512 + threadIdx.x; i < NTS * D / 4; i += gridDim.x * 512) { f32x4 v = (f32x4){0.f, 0.f, 0.f, 0.f};
#pragma unroll
                for (int sidx = 0; sidx < 8; ++sidx) { const u32x2 h = tz[(size_t)sidx * (NTS * D / 4) + i]; v += (f32x4){bflo(h.x), bfhi(h.x), bflo(h.y), bfhi(h.y)}; }
                u32x2 o; o.x = pk2(v[0], v[1]); o.y = pk2(v[2], v[3]); mo[i] = o; } }
    }
    PH_BEGIN(5) { pg8::TailOrder S; S.init(D, gridDim.x, blockIdx.x); pg8::Gemm g{(const bf16_t*)(p.ws + WS_MRG), (const bf16_t*)(p.ws + WS_WOUT), NT, D, D};
        pg8::EpiRes<false> E{p.xp, p.xs, nullptr, NTP, (bf16_t*)(p.ws + WS_Z1), (bf16_t*)(p.ws + WS_PART)}; pg8::gemm_phase(lds, g, S, E); }
    PH_BEGIN(6) phase_ln<true>((const bf16_t*)(p.ws + WS_Z1), p.xs, nullptr, (const bf16_t*)(p.ws + WS_PART), p.ln1g, p.ln1b, nullptr, (bf16_t*)(p.ws + WS_X1B));
    PH_BEGIN(7) { pg8::StaticOrder S; S.init(NT, DFF, D, gridDim.x, blockIdx.x); pg8::Gemm g{(const bf16_t*)(p.ws + WS_X1B), (const bf16_t*)(p.ws + WS_WUP), NT, DFF, D};
        pg8::EpiHid E{(bf16_t*)(p.ws + WS_HID), DFF}; pg8::gemm_phase(lds, g, S, E); }
    PH_BEGIN(8) { pg8::TailOrder S; S.init(DFF, gridDim.x, blockIdx.x); pg8::Gemm g{(const bf16_t*)(p.ws + WS_HID), (const bf16_t*)(p.ws + WS_WDN), NT, D, DFF};
        pg8::EpiRes<true> E{nullptr, nullptr, (const bf16_t*)(p.ws + WS_X1B), NT, (bf16_t*)(p.ws + WS_Z2), (bf16_t*)(p.ws + WS_PART)}; pg8::gemm_phase(lds, g, S, E); }
    PH_BEGIN(9) phase_ln<false>((const bf16_t*)(p.ws + WS_Z2), nullptr, (const bf16_t*)(p.ws + WS_X1B), (const bf16_t*)(p.ws + WS_PART), p.ln2g, p.ln2b, p.out + O_Y, nullptr);
}

#ifndef MK_MULTI
#define MK_MULTI 0
#endif
extern "C" void kernel_launch(void* const* d_in, const int* in_sizes, int n_in, void* d_out, int out_size, void* d_ws, size_t ws_size, hipStream_t stream) {
    static int grid = 0;
    if (grid == 0) {
        int dev = 0, cus = 0, per = 0;
        if (n_in != 21 || ws_size < WS_END) { fprintf(stderr, "kernel_launch: unexpected n_in %d / ws_size %zu (need %zu)\n", n_in, ws_size, (size_t)WS_END); grid = -1; return; }
        (void)hipGetDevice(&dev);
        (void)hipDeviceGetAttribute(&cus, hipDeviceAttributeMultiprocessorCount, dev);
        (void)hipFuncSetAttribute((const void*)mega, hipFuncAttributeMaxDynamicSharedMemorySize, LDS_BYTES);
        (void)hipOccupancyMaxActiveBlocksPerMultiprocessor(&per, (const void*)mega, 512, LDS_BYTES);
        if (per < 1) { fprintf(stderr, "kernel_launch: occupancy query says %d blocks per CU\n", per); per = 1; }
        grid = cus;
    }
    if (grid < 0) return;
    (void)hipMemsetAsync((char*)d_ws + WS_CTL, 0, 32768, stream);
    Params p{};
    const float** pp = (const float**)&p;
    for (int i = 0; i < 21; ++i) pp[i] = (const float*)d_in[i];
    p.out = (float*)d_out; p.ws = (unsigned char*)d_ws; p.rep = 2;
#if MK_MULTI
    for (int ph = 0; ph < N_PHASES; ++ph) { p.ph_lo = ph; p.ph_hi = ph + 1; hipLaunchKernelGGL(mega, dim3(grid), dim3(512), LDS_BYTES, stream, p); }
#else
    p.ph_lo = 0; p.ph_hi = N_PHASES;
    void* args[] = {&p};
    hipError_t e = hipLaunchCooperativeKernel((const void*)mega, dim3(grid), dim3(512), args, LDS_BYTES, stream);
    if (e != hipSuccess) fprintf(stderr, "kernel_launch: cooperative launch failed: %s (grid %d)\n", hipGetErrorString(e), grid);
#endif
}
```
